# Optimizing an MI355X kernel written in HIP

```python
import math
import jax, jax.numpy as jnp
from jax import lax
import numpy as np

D_MODEL = 1024
BATCH = 16
SEQ = 2048
DEPTH = 1
DEC_BATCH = 16
DEC_SEQ = 64
PAST_LEN = 4096

CHUNK = 64
Q_BLOCK = 128
MIX_WIDTH = D_MODEL
DIFF_WIDTH = MIX_WIDTH // 2
SB_WIDTH = MIX_WIDTH - DIFF_WIDTH
DIFF_HEADS = 4
DIFF_QK_DIM = 64
DIFF_V_DIM = DIFF_WIDTH // DIFF_HEADS
DIFF_QK_WIDTH = DIFF_HEADS * 2 * DIFF_QK_DIM
SB_HEADS = 8
SB_HEAD_DIM = SB_WIDTH // SB_HEADS
IN_WIDTH = 2 * DIFF_QK_WIDTH + DIFF_WIDTH + 3 * SB_WIDTH
D_FF = -(-8 * D_MODEL // (3 * 256)) * 256
RMS_EPS = 1e-6
NEG_INF = -1e30

kernel_name = 'hymba_diff_stickbreak_stream_step'


def _rms_norm(x, g):
    xf = x.astype(jnp.float32)
    y = xf * lax.rsqrt(jnp.mean(xf * xf, axis=-1, keepdims=True) + RMS_EPS)
    return (y * g.astype(jnp.float32)).astype(x.dtype)


def _alibi_slopes():
    return jnp.exp2(-8.0 / DIFF_HEADS * jnp.arange(1, DIFF_HEADS + 1, dtype=jnp.float32))


def _lambda_init(layer):
    return 0.8 - 0.6 * math.exp(-0.3 * layer)


def _project(n, w_in):
    B, T, _ = n.shape
    qkv = n @ w_in.astype(n.dtype)
    o1 = DIFF_QK_WIDTH
    o2 = o1 + DIFF_QK_WIDTH
    o3 = o2 + DIFF_WIDTH
    o4 = o3 + SB_WIDTH
    o5 = o4 + SB_WIDTH
    qd = qkv[..., :o1].reshape(B, T, DIFF_HEADS, 2 * DIFF_QK_DIM)
    kd = qkv[..., o1:o2].reshape(B, T, DIFF_HEADS, 2 * DIFF_QK_DIM)
    vd = qkv[..., o2:o3].reshape(B, T, DIFF_HEADS, DIFF_V_DIM)
    qs = qkv[..., o3:o4].reshape(B, T, SB_HEADS, SB_HEAD_DIM)
    ks = qkv[..., o4:o5].reshape(B, T, SB_HEADS, SB_HEAD_DIM)
    vs = qkv[..., o5:].reshape(B, T, SB_HEADS, SB_HEAD_DIM)
    return qd, kd, vd, qs, ks, vs


def _diff_attention(q, k, v, q_pos, k_pos, lam, lam_init, subln_g):
    B, Tq = q.shape[0], q.shape[1]
    Tk = k.shape[1]
    qf = q.astype(jnp.float32).reshape(B, Tq, DIFF_HEADS, 2, DIFF_QK_DIM)
    kf = k.astype(jnp.float32).reshape(B, Tk, DIFF_HEADS, 2, DIFF_QK_DIM)
    s = jnp.einsum('bqhmd,bkhmd->bhmqk', qf, kf) * (DIFF_QK_DIM ** -0.5)
    dist = jnp.abs(q_pos[:, None] - k_pos[None, :]).astype(jnp.float32)
    bias = -_alibi_slopes()[:, None, None] * dist
    visible = (k_pos[None, :] // CHUNK) <= (q_pos[:, None] // CHUNK)
    s = jnp.where(visible, s + bias[None, :, None], NEG_INF)
    p = jax.nn.softmax(s, axis=-1)
    a = p[:, :, 0] - lam * p[:, :, 1]
    o = jnp.einsum('bhqk,bkhd->bqhd', a, v.astype(jnp.float32))
    o = o * lax.rsqrt(jnp.mean(o * o, axis=-1, keepdims=True) + RMS_EPS)
    o = o * subln_g.astype(jnp.float32) * (1.0 - lam_init)
    return o.reshape(B, Tq, DIFF_WIDTH)


def _stick_breaking(q, k, v, q_pos, k_pos):
    B, Tq = q.shape[0], q.shape[1]
    z = jnp.einsum('bqhd,bkhd->bhqk', q.astype(jnp.float32), k.astype(jnp.float32)) * (SB_HEAD_DIM ** -0.5)
    causal = k_pos[None, :] < q_pos[:, None]
    log_keep = jnp.where(causal, jax.nn.log_sigmoid(-z), 0.0)
    after = lax.cumsum(log_keep, axis=3, reverse=True) - log_keep
    a = jnp.where(causal, jnp.exp(jax.nn.log_sigmoid(z) + after), 0.0)
    o = jnp.einsum('bhqk,bkhd->bqhd', a, v.astype(jnp.float32))
    return o.reshape(B, Tq, SB_WIDTH)


def _swiglu(h, g, w_gate, w_up, w_down):
    n = _rms_norm(h, g)
    dt = n.dtype
    return (jax.nn.silu(n @ w_gate.astype(dt)) * (n @ w_up.astype(dt))) @ w_down.astype(dt)


def setup_inputs(seed: int = 0) -> dict:
    key = jax.random.key(seed)
    ks = jax.random.split(key, 20)
    f32 = jnp.float32
    nrm = lambda k, shape, scale: jax.random.normal(k, shape, f32) * scale
    return {
        'x_prompt': nrm(ks[0], (BATCH, SEQ, D_MODEL), 1.0),
        'x_sample': nrm(ks[1], (DEC_BATCH, DEC_SEQ, D_MODEL), 1.0),
        'cache_diff_k': nrm(ks[2], (DEPTH, DEC_BATCH, PAST_LEN, DIFF_HEADS, 2 * DIFF_QK_DIM), 1.0),
        'cache_diff_v': nrm(ks[3], (DEPTH, DEC_BATCH, PAST_LEN, DIFF_HEADS, DIFF_V_DIM), 1.0),
        'cache_sb_k': nrm(ks[4], (DEPTH, DEC_BATCH, PAST_LEN, SB_HEADS, SB_HEAD_DIM), 1.0),
        'cache_sb_v': nrm(ks[5], (DEPTH, DEC_BATCH, PAST_LEN, SB_HEADS, SB_HEAD_DIM), 1.0),
        'norm_attn_g': 1.0 + nrm(ks[6], (DEPTH, D_MODEL), 0.02),
        'w_in': nrm(ks[7], (DEPTH, D_MODEL, IN_WIDTH), D_MODEL ** -0.5),
        'lambda_q1': nrm(ks[8], (DEPTH, DIFF_QK_DIM), 0.1),
        'lambda_k1': nrm(ks[9], (DEPTH, DIFF_QK_DIM), 0.1),
        'lambda_q2': nrm(ks[10], (DEPTH, DIFF_QK_DIM), 0.1),
        'lambda_k2': nrm(ks[11], (DEPTH, DIFF_QK_DIM), 0.1),
        'diff_subln_g': 1.0 + nrm(ks[12], (DEPTH, DIFF_V_DIM), 0.02),
        'w_out': nrm(ks[13], (DEPTH, MIX_WIDTH, D_MODEL), MIX_WIDTH ** -0.5),
        'norm_ffn_g': 1.0 + nrm(ks[14], (DEPTH, D_MODEL), 0.02),
        'w_gate': nrm(ks[15], (DEPTH, D_MODEL, D_FF), D_MODEL ** -0.5),
        'w_up': nrm(ks[16], (DEPTH, D_MODEL, D_FF), D_MODEL ** -0.5),
        'w_down': nrm(ks[17], (DEPTH, D_FF, D_MODEL), D_FF ** -0.5),
        'norm_final_g': 1.0 + nrm(ks[18], (D_MODEL,), 0.02),
    }


def reference(x_prompt, x_sample, cache_diff_k, cache_diff_v, cache_sb_k, cache_sb_v,
              norm_attn_g, w_in, lambda_q1, lambda_k1, lambda_q2, lambda_k2, diff_subln_g,
              w_out, norm_ffn_g, w_gate, w_up, w_down, norm_final_g):
    xp = x_prompt
    xs = x_sample
    pos_prompt = jnp.arange(SEQ, dtype=jnp.int32)
    dec_seq = x_sample.shape[1]
    pos_sample_q = PAST_LEN + jnp.arange(dec_seq, dtype=jnp.int32)
    pos_sample_k = jnp.arange(PAST_LEN + dec_seq, dtype=jnp.int32)
    p_dk, p_dv, p_sk, p_sv = [], [], [], []
    s_dk, s_dv, s_sk, s_sv = [], [], [], []
    for l in range(DEPTH):
        lam_init = _lambda_init(l)
        lam = (jnp.exp(jnp.sum(lambda_q1[l].astype(jnp.float32) * lambda_k1[l].astype(jnp.float32)))
               - jnp.exp(jnp.sum(lambda_q2[l].astype(jnp.float32) * lambda_k2[l].astype(jnp.float32)))
               + lam_init)

        n = _rms_norm(xp, norm_attn_g[l])
        qd, kd, vd, qs, ks_, vs = _project(n, w_in[l])

        def prompt_block(b):
            start = b * Q_BLOCK
            qpos = start + jnp.arange(Q_BLOCK, dtype=jnp.int32)
            qd_b = lax.dynamic_slice_in_dim(qd, start, Q_BLOCK, axis=1)
            qs_b = lax.dynamic_slice_in_dim(qs, start, Q_BLOCK, axis=1)
            od = _diff_attention(qd_b, kd, vd, qpos, pos_prompt, lam, lam_init, diff_subln_g[l])
            osb = _stick_breaking(qs_b, ks_, vs, qpos, pos_prompt)
            return jnp.concatenate([od, osb], axis=-1)

        blocks = lax.map(prompt_block, jnp.arange(SEQ // Q_BLOCK, dtype=jnp.int32))
        mixed = jnp.transpose(blocks, (1, 0, 2, 3)).reshape(xp.shape[0], SEQ, MIX_WIDTH).astype(xp.dtype)
        hp = xp + mixed @ w_out[l].astype(xp.dtype)
        xp = hp + _swiglu(hp, norm_ffn_g[l], w_gate[l], w_up[l], w_down[l])
        p_dk.append(kd); p_dv.append(vd); p_sk.append(ks_); p_sv.append(vs)

        n = _rms_norm(xs, norm_attn_g[l])
        qd2, kd2, vd2, qs2, ks2, vs2 = _project(n, w_in[l])
        kd_all = jnp.concatenate([cache_diff_k[l].astype(kd2.dtype), kd2], axis=1)
        vd_all = jnp.concatenate([cache_diff_v[l].astype(vd2.dtype), vd2], axis=1)
        ks_all = jnp.concatenate([cache_sb_k[l].astype(ks2.dtype), ks2], axis=1)
        vs_all = jnp.concatenate([cache_sb_v[l].astype(vs2.dtype), vs2], axis=1)
        od = _diff_attention(qd2, kd_all, vd_all, pos_sample_q, pos_sample_k, lam, lam_init, diff_subln_g[l])
        osb = _stick_breaking(qs2, ks_all, vs_all, pos_sample_q, pos_sample_k)
        mixed_s = jnp.concatenate([od, osb], axis=-1).astype(xs.dtype)
        hs = xs + mixed_s @ w_out[l].astype(xs.dtype)
        xs = hs + _swiglu(hs, norm_ffn_g[l], w_gate[l], w_up[l], w_down[l])
        s_dk.append(kd2); s_dv.append(vd2); s_sk.append(ks2); s_sv.append(vs2)

    y_prompt = _rms_norm(xp, norm_final_g)
    y_sample = _rms_norm(xs, norm_final_g)
    prompt_diff_k = jnp.stack(p_dk)
    prompt_diff_v = jnp.stack(p_dv)
    prompt_sb_k = jnp.stack(p_sk)
    prompt_sb_v = jnp.stack(p_sv)
    sample_diff_k = jnp.stack(s_dk)
    sample_diff_v = jnp.stack(s_dv)
    sample_sb_k = jnp.stack(s_sk)
    sample_sb_v = jnp.stack(s_sv)
    return (y_prompt, y_sample, prompt_diff_k, prompt_diff_v, prompt_sb_k, prompt_sb_v,
            sample_diff_k, sample_diff_v, sample_sb_k, sample_sb_v)
```

```cpp
#include <hip/hip_runtime.h>
#include <hip/hip_cooperative_groups.h>
#include <cstdio>
#include <cstdint>
namespace cg = cooperative_groups;
namespace pg8 {
#define PG8_LAS __attribute__((address_space(3)))
typedef unsigned short bf16_t;
typedef short bf16x8 __attribute__((ext_vector_type(8)));
typedef float f32x4 __attribute__((ext_vector_type(4)));
typedef unsigned u32x4 __attribute__((ext_vector_type(4)));
constexpr int BM = 256, BK = 64, HALF = 128, HTB = HALF * BK * 2  , STAGE_BYTES = 8 * HTB, NXCD = 8, WGM = 8;

__host__ __device__ __forceinline__ int lds_byte(int r, int c) { const int st = (r >> 4) * 2 + (c >> 5), rr = r & 15, cc = c & 31, ob = rr * 64 + cc * 2; return st * 1024 + (ob ^ (((ob >> 9) & 1) << 5)); }
__host__ __device__ __forceinline__ void stage_rc(int b, int& R, int& C) { const int st = b / 1024, sb = b % 1024, swz = sb ^ (((sb >> 9) & 1) << 5); R = (st >> 1) * 16 + swz / 64; C = (st & 1) * 32 + (swz % 64) / 2; }
__host__ __device__ __forceinline__ int perm32(int rho) { const int n = rho >> 4, i = rho & 15; return 8 * (i >> 2) + 4 * n + (i & 3); }

struct Unit { int pm, pn; };
struct Gemm { const bf16_t* A; const bf16_t* Bt; int M, N, K; };

struct StaticOrder {
    int nM, nN, nwg, G, c;
    __host__ __device__ void init(int M, int N, int G_, int c_) { nM = M / BM; nN = N / BM; nwg = nM * nN; G = G_; c = c_; }
    __host__ __device__ bool next(int i, Unit& u) const {
        const long L = (long)i * G + c; if (L >= nwg) return false;
        int wgid = (int)L; { const int q = nwg / NXCD, r = nwg % NXCD, xcd = wgid % NXCD, off = wgid / NXCD; wgid = (xcd < r ? xcd * (q + 1) : r * (q + 1) + (xcd - r) * q) + off; }
        const int nig = WGM * nN, gid = wgid / nig, fm = gid * WGM, gsz = (nM - fm) < WGM ? (nM - fm) : WGM;
        u.pm = fm + ((wgid % nig) % gsz); u.pn = (wgid % nig) / gsz; return true;
    }
    __device__ __forceinline__ void a_ready(const Unit&) const {}
    __device__ __forceinline__ void done(const Unit&) const {}
};

__device__ __forceinline__ unsigned cvt_pk_bf16(float lo, float hi) { unsigned r; asm volatile("v_cvt_pk_bf16_f32 %0, %1, %2" : "=v"(r) : "v"(lo), "v"(hi)); return r; }
typedef float f32x2 __attribute__((ext_vector_type(2)));

constexpr int MT = 33792;
constexpr int MP = 32768;
constexpr size_t OFF_PKV = (size_t)MT * 1024;
constexpr size_t OFF_SKV = OFF_PKV + 4ull * MP * 512;
constexpr float RMS_EPS = 1e-6f;
constexpr float LOG2E = 1.4426950408889634f;
typedef float f32x2 __attribute__((ext_vector_type(2)));

struct EpiQKV {
    static constexpr bool PERM = true, AFTER_DRAIN = false;
    bf16_t* qkv; float* out; float qscale;
    __device__ __forceinline__ void operator()(const f32x4 (&acc)[2][2][4][2], const Unit& u, int wr, int wc, int fr, int fq) const {
        const int seg = u.pn >> 1;
        const bool isq = (seg == 0) || (seg == 3);
        const float sc = isq ? qscale : 1.f;
        const int row0 = u.pm * BM + wr * 64 + fr, col0 = u.pn * BM + wc * 32 + 8 * fq;
        const int oi = (seg == 1) ? 0 : (seg == 2) ? 1 : (seg == 4) ? 2 : 3;
        const bool prompt = u.pm < (MP / BM);
        float* obase = prompt ? out + OFF_PKV + (size_t)oi * ((size_t)MP * 512) : out + OFF_SKV + (size_t)oi * (1024 * 512);
        const int orow0 = prompt ? row0 : row0 - MP;
        const int ocol0 = (u.pn & 1) * 256 + wc * 32 + 8 * fq;
#pragma unroll
        for (int ai = 0; ai < 2; ++ai)
#pragma unroll
            for (int m = 0; m < 4; ++m) {
                const int rr = ai * HALF + m * 16;
#pragma unroll
                for (int bj = 0; bj < 2; ++bj) {
                    const f32x4 v0 = acc[ai][bj][m][0], v1 = acc[ai][bj][m][1];
                    if (!isq) { float* op = obase + (size_t)(orow0 + rr) * 512 + ocol0 + bj * HALF; *(f32x4*)op = v0; *(f32x4*)(op + 4) = v1; }
                    u32x4 w; w.x = cvt_pk_bf16(v0[0] * sc, v0[1] * sc); w.y = cvt_pk_bf16(v0[2] * sc, v0[3] * sc); w.z = cvt_pk_bf16(v1[0] * sc, v1[1] * sc); w.w = cvt_pk_bf16(v1[2] * sc, v1[3] * sc);
                    *(u32x4*)(qkv + (size_t)(row0 + rr) * 3072 + col0 + bj * HALF) = w;
                }
            }
    }
};

struct EpiRes {
    static constexpr bool PERM = true, AFTER_DRAIN = false;
    const float* bp; const float* bs; float* Y; bf16_t* hb; float* ssq;
    __device__ __forceinline__ void operator()(const f32x4 (&acc)[2][2][4][2], const Unit& u, int wr, int wc, int fr, int fq) const {
        const int row0 = u.pm * BM + wr * 64 + fr, col0 = u.pn * BM + wc * 32 + 8 * fq;
        const bool prompt = u.pm < (MP / BM);
#pragma unroll
        for (int ai = 0; ai < 2; ++ai)
#pragma unroll
            for (int m = 0; m < 4; ++m) {
                const int row = row0 + ai * HALF + m * 16;
                const float* b = prompt ? bp + (size_t)row * 1024 : bs + (size_t)(row - MP) * 1024;
                float s = 0.f;
#pragma unroll
                for (int bj = 0; bj < 2; ++bj) {
                    const int col = col0 + bj * HALF;
                    const f32x4 v0 = acc[ai][bj][m][0] + *(const f32x4*)(b + col), v1 = acc[ai][bj][m][1] + *(const f32x4*)(b + col + 4);
                    float* yp = Y + (size_t)row * 1024 + col; *(f32x4*)yp = v0; *(f32x4*)(yp + 4) = v1;
                    if (hb) { u32x4 w; w.x = cvt_pk_bf16(v0[0], v0[1]); w.y = cvt_pk_bf16(v0[2], v0[3]); w.z = cvt_pk_bf16(v1[0], v1[1]); w.w = cvt_pk_bf16(v1[2], v1[3]);
                        *(u32x4*)(hb + (size_t)row * 1024 + col) = w; }
                    s += (v0[0] * v0[0] + v0[1] * v0[1]) + (v0[2] * v0[2] + v0[3] * v0[3]) + (v1[0] * v1[0] + v1[1] * v1[1]) + (v1[2] * v1[2] + v1[3] * v1[3]);
                }
                s += __shfl_xor(s, 16); s += __shfl_xor(s, 32);
                if (fq == 0) ssq[((size_t)u.pn * MT + row) * 4 + wc] = s;
            }
    }
};

struct EpiSwiGLU {
    static constexpr bool PERM = true, AFTER_DRAIN = false;
    bf16_t* act; const float* ssq;
    __device__ __forceinline__ void operator()(const f32x4 (&acc)[2][2][4][2], const Unit& u, int wr, int wc, int fr, int fq) const {
        const int row0 = u.pm * BM + wr * 64 + fr, col0 = u.pn * HALF + wc * 32 + 8 * fq;
#pragma unroll
        for (int ai = 0; ai < 2; ++ai)
#pragma unroll
            for (int m = 0; m < 4; ++m) {
                const int row = row0 + ai * HALF + m * 16;
                const f32x4 a = *(const f32x4*)(ssq + (size_t)row * 4), b = *(const f32x4*)(ssq + ((size_t)MT + row) * 4), c = *(const f32x4*)(ssq + ((size_t)2 * MT + row) * 4), d = *(const f32x4*)(ssq + ((size_t)3 * MT + row) * 4);
                const float tot = ((a[0] + a[1]) + (a[2] + a[3])) + ((b[0] + b[1]) + (b[2] + b[3])) + ((c[0] + c[1]) + (c[2] + c[3])) + ((d[0] + d[1]) + (d[2] + d[3]));
                const float rstd = __builtin_amdgcn_rsqf(tot * (1.0f / 1024.0f) + RMS_EPS);
                float o[8];
#pragma unroll
                for (int n = 0; n < 2; ++n)
#pragma unroll
                    for (int i = 0; i < 4; ++i) {
                        const float g = acc[ai][0][m][n][i] * rstd, up = acc[ai][1][m][n][i] * rstd;
                        o[n * 4 + i] = g * __builtin_amdgcn_rcpf(1.f + __builtin_amdgcn_exp2f(__builtin_fmaxf(-g * LOG2E, -126.f))) * up;
                    }
                u32x4 w; w.x = cvt_pk_bf16(o[0], o[1]); w.y = cvt_pk_bf16(o[2], o[3]); w.z = cvt_pk_bf16(o[4], o[5]); w.w = cvt_pk_bf16(o[6], o[7]);
                *(u32x4*)(act + (size_t)row * 2816 + col0) = w;
            }
    }
};
template <class Epi, class Sched, bool ALIGN_EPI = false, bool SP2 = false>
__device__ __forceinline__ void gemm_phase(PG8_LAS unsigned char* lds, const Gemm g, const Sched& S, const Epi& E) {
    const int tid = threadIdx.x, wid = __builtin_amdgcn_readfirstlane(tid >> 6), lane = tid & 63, wr = wid >> 2, wc = wid & 3, fr = lane & 15, fq = lane >> 4;
    const int K = g.K, nt = K / BK;
    unsigned voffA[2], voffB[2];
#pragma unroll
    for (int i = 0; i < 2; ++i) { int R, C; stage_rc(tid * 16 + i * 8192, R, C); const int Rb = Epi::PERM ? ((R & ~31) + perm32(R & 31)) : R;
        voffA[i] = (unsigned)(R * K + C) * 2u; voffB[i] = (unsigned)(Rb * K + C) * 2u; }
    const size_t kstep = (size_t)(BK * 2);
    const size_t hstep = (size_t)HALF * K * 2;
    const size_t tstep = 2 * hstep;
    const unsigned ldsw = (unsigned)wid * 1024u;
    const int aoff = lds_byte(wr * 64 + fr, fq * 8), boff = lds_byte(wc * 32 + fr, fq * 8);
#define PG8_SA(b, h) (((b) * 2 + (h)) * HTB)
#define PG8_SB(b, h) ((4 + (b) * 2 + (h)) * HTB)
#define PG8_STAGE(bufoff, gbase, voff) do { _Pragma("unroll") for (int _i = 0; _i < 2; ++_i) \
        __builtin_amdgcn_global_load_lds((const unsigned*)((const char*)(gbase) + (voff)[_i]), (PG8_LAS unsigned*)(lds + (bufoff) + ldsw + _i * 8192), 16, 0, 0); } while (0)
#define PG8_LDA(dst, b, h) do { _Pragma("unroll") for (int m = 0; m < 4; ++m) _Pragma("unroll") for (int k = 0; k < 2; ++k) dst[m][k] = *(const PG8_LAS bf16x8*)(lds + PG8_SA(b, h) + aoff + m * 2048 + k * 1024); } while (0)
#define PG8_LDB(dst, b, h) do { _Pragma("unroll") for (int n = 0; n < 2; ++n) _Pragma("unroll") for (int k = 0; k < 2; ++k) dst[n][k] = *(const PG8_LAS bf16x8*)(lds + PG8_SB(b, h) + boff + n * 2048 + k * 1024); } while (0)
#define PG8_MMA(ai, bj, At, Bt) do { __builtin_amdgcn_s_setprio(1); _Pragma("unroll") for (int m = 0; m < 4; ++m) _Pragma("unroll") for (int n = 0; n < 2; ++n) _Pragma("unroll") for (int k = 0; k < 2; ++k) \
        acc[ai][bj][m][n] = __builtin_amdgcn_mfma_f32_16x16x32_bf16(Bt[n][k], At[m][k], acc[ai][bj][m][n], 0, 0, 0); __builtin_amdgcn_s_setprio(0); } while (0)
#define PG8_WAIT_V(n) asm volatile("s_waitcnt vmcnt(" #n ")" ::: "memory")
#define PG8_WAIT_L(n) asm volatile("s_waitcnt lgkmcnt(" #n ")" ::: "memory")
#define PG8_BAR __builtin_amdgcn_s_barrier()
#define PG8_SCHED __builtin_amdgcn_sched_barrier(0)
    Unit cur, nxt; int ui = 0;
    if (!S.next(0, cur)) return;
    f32x4 acc[2][2][4][2];
#pragma unroll
    for (int a = 0; a < 2; ++a)
#pragma unroll
        for (int b = 0; b < 2; ++b)
#pragma unroll
            for (int m = 0; m < 4; ++m)
#pragma unroll
                for (int n = 0; n < 2; ++n) acc[a][b][m][n] = (f32x4){0.f, 0.f, 0.f, 0.f};
    bf16x8 At[4][2], B0[2][2], B1[2][2];
    const char* cA = (const char*)g.A + (size_t)cur.pm * tstep; const char* cB = (const char*)g.Bt + (size_t)cur.pn * tstep;
    S.a_ready(cur);
    if constexpr (SP2) {
        PG8_STAGE(PG8_SB(0, 0), cB, voffB); PG8_STAGE(PG8_SB(0, 1), cB + hstep, voffB); PG8_STAGE(PG8_SA(0, 0), cA, voffA); PG8_STAGE(PG8_SA(0, 1), cA + hstep, voffA);
        if (wr == 1) PG8_BAR;
        PG8_WAIT_V(2); PG8_BAR;
        PG8_STAGE(PG8_SB(1, 0), cB + kstep, voffB); PG8_STAGE(PG8_SA(1, 0), cA + kstep, voffA); PG8_STAGE(PG8_SB(1, 1), cB + hstep + kstep, voffB);
        PG8_WAIT_V(6); PG8_BAR;
    } else {
        PG8_STAGE(PG8_SB(0, 0), cB, voffB); PG8_STAGE(PG8_SA(0, 0), cA, voffA); PG8_STAGE(PG8_SB(0, 1), cB + hstep, voffB); PG8_STAGE(PG8_SA(0, 1), cA + hstep, voffA);
        if (wr == 1) PG8_BAR;
        PG8_WAIT_V(4); PG8_BAR;
        PG8_STAGE(PG8_SB(1, 0), cB + kstep, voffB); PG8_STAGE(PG8_SA(1, 0), cA + kstep, voffA); PG8_STAGE(PG8_SB(1, 1), cB + hstep + kstep, voffB);
        PG8_WAIT_V(6); PG8_BAR;
    }
    for (;;) {
        const bool has_next = S.next(ui + 1, nxt);
        const char* nA = has_next ? (const char*)g.A + (size_t)nxt.pm * tstep : cA; const char* nB = has_next ? (const char*)g.Bt + (size_t)nxt.pn * tstep : cB;
        for (int t = 0; t < nt; t += 2) {
            const bool last = (t == nt - 2);
            const char* a1 = cA + (size_t)(t + 1) * kstep;
            const char* a2 = last ? nA : cA + (size_t)(t + 2) * kstep; const char* b2 = last ? nB : cB + (size_t)(t + 2) * kstep;
            const char* a3 = a2 + kstep; const char* b3 = b2 + kstep;
            if (last && has_next) S.a_ready(nxt);
            if constexpr (SP2) {
            PG8_LDB(B0, 0, 0); PG8_LDB(B1, 0, 1); PG8_SCHED; PG8_LDA(At, 0, 0); PG8_STAGE(PG8_SA(1, 1), a1 + hstep, voffA);
            PG8_WAIT_V(8); PG8_WAIT_L(0); PG8_BAR; PG8_MMA(0, 0, At, B0); PG8_MMA(0, 1, At, B1); PG8_BAR; PG8_SCHED;
            PG8_LDA(At, 0, 1); PG8_STAGE(PG8_SB(0, 0), b2, voffB); PG8_STAGE(PG8_SB(0, 1), b2 + hstep, voffB); PG8_STAGE(PG8_SA(0, 0), a2, voffA);
            PG8_WAIT_V(8); PG8_WAIT_L(0); PG8_BAR; PG8_MMA(1, 0, At, B0); PG8_MMA(1, 1, At, B1); PG8_BAR; PG8_SCHED;
            PG8_LDB(B0, 1, 0); PG8_LDB(B1, 1, 1); PG8_SCHED; PG8_LDA(At, 1, 0); PG8_STAGE(PG8_SA(0, 1), a2 + hstep, voffA);
            PG8_WAIT_V(8); PG8_WAIT_L(0); PG8_BAR; PG8_MMA(0, 0, At, B0); PG8_MMA(0, 1, At, B1); PG8_BAR; PG8_SCHED;
            PG8_LDA(At, 1, 1); PG8_STAGE(PG8_SB(1, 0), b3, voffB); PG8_STAGE(PG8_SB(1, 1), b3 + hstep, voffB); PG8_STAGE(PG8_SA(1, 0), a3, voffA);
            PG8_WAIT_V(8); PG8_WAIT_L(0); PG8_BAR; PG8_MMA(1, 0, At, B0); PG8_MMA(1, 1, At, B1); PG8_BAR; PG8_SCHED;
            } else {
            PG8_LDB(B0, 0, 0); PG8_SCHED; PG8_LDA(At, 0, 0); PG8_STAGE(PG8_SA(1, 1), a1 + hstep, voffA);
            PG8_WAIT_L(8); PG8_BAR; PG8_WAIT_L(0); PG8_MMA(0, 0, At, B0); PG8_BAR; PG8_SCHED;
            PG8_LDB(B1, 0, 1); PG8_STAGE(PG8_SB(0, 0), b2, voffB);
            PG8_BAR; PG8_WAIT_L(0); PG8_MMA(0, 1, At, B1); PG8_BAR;
            PG8_LDA(At, 0, 1); PG8_STAGE(PG8_SA(0, 0), a2, voffA);
            PG8_BAR; PG8_WAIT_L(0); PG8_MMA(1, 0, At, B0); PG8_BAR; PG8_SCHED;
            PG8_STAGE(PG8_SB(0, 1), b2 + hstep, voffB);
            PG8_WAIT_V(6); PG8_BAR; PG8_MMA(1, 1, At, B1); PG8_BAR;
            PG8_LDB(B0, 1, 0); PG8_SCHED; PG8_LDA(At, 1, 0); PG8_STAGE(PG8_SA(0, 1), a2 + hstep, voffA);
            PG8_WAIT_L(8); PG8_BAR; PG8_WAIT_L(0); PG8_MMA(0, 0, At, B0); PG8_BAR; PG8_SCHED;
            PG8_LDB(B1, 1, 1); PG8_STAGE(PG8_SB(1, 0), b3, voffB);
            PG8_BAR; PG8_WAIT_L(0); PG8_MMA(0, 1, At, B1); PG8_BAR;
            PG8_LDA(At, 1, 1); PG8_STAGE(PG8_SA(1, 0), a3, voffA);
            PG8_BAR; PG8_WAIT_L(0); PG8_MMA(1, 0, At, B0); PG8_BAR; PG8_SCHED;
            PG8_STAGE(PG8_SB(1, 1), b3 + hstep, voffB);
            PG8_WAIT_V(6); PG8_BAR; PG8_MMA(1, 1, At, B1); PG8_BAR;
            }
        }
        if constexpr (ALIGN_EPI) { if (wr == 0) PG8_BAR; }
        if constexpr (!Epi::AFTER_DRAIN) { E(acc, cur, wr, wc, fr, fq); S.done(cur); }
        if (!has_next) break;
#pragma unroll
        for (int a = 0; a < 2; ++a)
#pragma unroll
            for (int b = 0; b < 2; ++b)
#pragma unroll
                for (int m = 0; m < 4; ++m)
#pragma unroll
                    for (int n = 0; n < 2; ++n) acc[a][b][m][n] = (f32x4){0.f, 0.f, 0.f, 0.f};
        cur = nxt; cA = nA; cB = nB; ++ui;
        if constexpr (ALIGN_EPI) { if (wr == 1) PG8_BAR; }
    }
    PG8_WAIT_V(0);
    if constexpr (!ALIGN_EPI) { if (wr == 0) PG8_BAR; }
    PG8_BAR;
    if constexpr (Epi::AFTER_DRAIN) { E.fused(acc, cur, wr, wc, fr, fq, lds, wid, lane); S.done(cur); }
#undef PG8_SA
#undef PG8_SB
#undef PG8_STAGE
#undef PG8_LDA
#undef PG8_LDB
#undef PG8_MMA
#undef PG8_WAIT_V
#undef PG8_WAIT_L
#undef PG8_BAR
#undef PG8_SCHED
}
}

namespace att {
#define LAS __attribute__((address_space(3)))
typedef short bf16x8 __attribute__((ext_vector_type(8)));
typedef short s16x4 __attribute__((ext_vector_type(4)));
typedef float f32x16 __attribute__((ext_vector_type(16)));
typedef float f32x4 __attribute__((ext_vector_type(4)));
typedef unsigned u32x4 __attribute__((ext_vector_type(4)));
typedef unsigned u32x2 __attribute__((ext_vector_type(2)));
typedef LAS unsigned char lchar;
typedef unsigned short bf16_t;
constexpr int MP = 32768, LDQ = 3072;
constexpr float LOG2E = 1.4426950408889634f;
constexpr float C2 = 0.125f * LOG2E;
constexpr float NEG_BIG = -1e30f;

struct Params {
    const bf16_t* qkv;
    const float *cdk, *cdv, *csk, *csv;
    bf16_t* mixed;
    unsigned* queue;
    float lam;
};

__device__ __forceinline__ int crow(int r, int hi) { return (r & 3) + 8 * (r >> 2) + 4 * hi; }
typedef float f32x2_t __attribute__((ext_vector_type(2))); typedef __bf16 bf16x2_t __attribute__((ext_vector_type(2)));
__device__ __forceinline__ unsigned cvtpk(float lo, float hi) { const f32x2_t v = {lo, hi}; const bf16x2_t b = __builtin_convertvector(v, bf16x2_t); return __builtin_bit_cast(unsigned, b); }
__device__ __forceinline__ u32x4 pack8(f32x4 a, f32x4 b) { u32x4 w; w.x = cvtpk(a[0], a[1]); w.y = cvtpk(a[2], a[3]); w.z = cvtpk(b[0], b[1]); w.w = cvtpk(b[2], b[3]); return w; }
__device__ __forceinline__ bf16x8 vfrag(const lchar* p0, const lchar* p1) {
    const s16x4 a = __builtin_bit_cast(s16x4, __builtin_amdgcn_ds_read_tr16_b64_v4i16((LAS s16x4*)p0));
    const s16x4 b = __builtin_bit_cast(s16x4, __builtin_amdgcn_ds_read_tr16_b64_v4i16((LAS s16x4*)p1));
    return (bf16x8){a[0], a[1], a[2], a[3], b[0], b[1], b[2], b[3]};
}
__device__ __forceinline__ bf16x8 pfrag(const f32x16& p, int s) {
    u32x4 w; w.x = cvtpk(p[8 * s + 0], p[8 * s + 1]); w.y = cvtpk(p[8 * s + 2], p[8 * s + 3]); w.z = cvtpk(p[8 * s + 4], p[8 * s + 5]); w.w = cvtpk(p[8 * s + 6], p[8 * s + 7]);
    return __builtin_bit_cast(bf16x8, w);
}
__device__ __forceinline__ int offKd(int row, int ch) { return row * 256 + ((ch ^ (row & 15)) << 4); }
__device__ __forceinline__ int offVd(int row, int ch) { return row * 256 + ((ch ^ (((row & 3) << 2) | ((row >> 2) & 3))) << 4); }
__device__ __forceinline__ int offKs(int row, int ch) { return row * 128 + ((ch ^ (row & 7)) << 4); }
__device__ __forceinline__ int offVs(int row, int ch) { return row * 128 + ((ch ^ (((row >> 1) & 1) << 2)) << 4); }

constexpr int DBUF = 32768;
constexpr int SBUF = 16384;

__device__ __forceinline__ void diff_sub(const lchar* Kb, const lchar* Vb, int sub, int map, const bf16x8 (&qf)[4], f32x16 (&O)[4],
                                         float& m0, float& l0, float dq, float sl2, int lane) {
    const int r32 = lane & 31, hi = lane >> 5;
    f32x16 s;
#pragma unroll
    for (int r = 0; r < 16; ++r) s[r] = -sl2 * __builtin_fabsf(dq - (float)((r & 3) + 8 * (r >> 2)));
    const int krow = sub * 32 + r32;
    bf16x8 kf[4];
#pragma unroll
    for (int ds = 0; ds < 4; ++ds) kf[ds] = *(const LAS bf16x8*)(Kb + offKd(krow, 8 * map + 2 * ds + hi));
    const int q4 = (lane & 15) >> 2, p = lane & 3, g1 = (lane >> 4) & 1;
    bf16x8 vf[2][4];
#pragma unroll
    for (int sk = 0; sk < 2; ++sk)
#pragma unroll
        for (int d = 0; d < 4; ++d) {
            const int ch = d * 4 + 2 * g1 + (p >> 1);
            const int ra = sub * 32 + 16 * sk + 4 * hi + q4, rb = ra + 8;
            vf[sk][d] = vfrag(Vb + offVd(ra, ch) + 8 * (p & 1), Vb + offVd(rb, ch) + 8 * (p & 1));
        }
#pragma unroll
    for (int ds = 0; ds < 4; ++ds) s = __builtin_amdgcn_mfma_f32_32x32x16_bf16(kf[ds], qf[ds], s, 0, 0, 0);
    float mx = s[0];
#pragma unroll
    for (int r = 1; r < 16; ++r) mx = __builtin_fmaxf(mx, s[r]);
    mx = __builtin_fmaxf(mx, __shfl_xor(mx, 32));
    const float n0 = __builtin_fmaxf(m0, mx);
    if (__any(n0 > m0 + 8.f)) {
        const float f0 = __builtin_amdgcn_exp2f(__builtin_fmaxf(m0 - n0, -200.f));
        l0 *= f0;
#pragma unroll
        for (int d = 0; d < 4; ++d)
#pragma unroll
            for (int r = 0; r < 16; ++r) O[d][r] *= f0;
        m0 = n0;
    }
    float a0 = 0.f;
#pragma unroll
    for (int r = 0; r < 16; ++r) { s[r] = __builtin_amdgcn_exp2f(__builtin_fmaxf(s[r] - m0, -200.f)); a0 += s[r]; }
    l0 += a0;
    bf16x8 p0[2];
    p0[0] = pfrag(s, 0); p0[1] = pfrag(s, 1);
#pragma unroll
    for (int sk = 0; sk < 2; ++sk)
#pragma unroll
        for (int d = 0; d < 4; ++d) O[d] = __builtin_amdgcn_mfma_f32_32x32x16_bf16(vf[sk][d], p0[sk], O[d], 0, 0, 0);
}

__device__ __forceinline__ u32x4 ld_f32x8_bf16(const float* p) { const f32x4 a = *(const f32x4*)p, b = *(const f32x4*)(p + 4); return pack8(a, b); }

template <bool SAMPLE>
__device__ __forceinline__ void diff_unit(lchar* lds, const Params& P, const LAS float* gt, int b, int h, int qb) {
    int tid_ = threadIdx.x; asm volatile("" : "+v"(tid_));
    const int tid = tid_, lane = tid & 63, wid = __builtin_amdgcn_readfirstlane(tid >> 6), r32 = lane & 31, hi = lane >> 5;
    const int map = wid & 1, qg = SAMPLE ? ((wid >> 1) & 1) : (wid >> 1);
    const int q0 = SAMPLE ? 0 : qb * 128;
    const size_t qrow_g = SAMPLE ? (size_t)MP + b * 64 + qg * 32 + r32 : (size_t)b * 2048 + q0 + qg * 32 + r32;
    const int qpos = SAMPLE ? 4096 + qg * 32 + r32 : q0 + qg * 32 + r32;
    const int ntiles = SAMPLE ? 65 : 2 * qb + 2;
    const int tw = SAMPLE ? 64 : (q0 + qg * 32) >> 6;
    const bool compute_wave = true;
    const bool epi_wave = SAMPLE ? (wid < 4) : true;
    const int ksub = wid >> 2;
    const float sl2 = __builtin_amdgcn_exp2f(-2.0f * (float)(h + 1)) * LOG2E;
    bf16x8 qf[4];
#pragma unroll
    for (int ds = 0; ds < 4; ++ds) qf[ds] = *(const bf16x8*)(P.qkv + qrow_g * LDQ + h * 128 + map * 64 + ds * 16 + hi * 8);
    f32x16 O[4];
#pragma unroll
    for (int d = 0; d < 4; ++d) O[d] = (f32x16){};
    float m0 = NEG_BIG, l0 = 0.f;

    auto kvbf = [&](int which, int t, int row, int ch) -> const bf16_t* {
        const size_t r = SAMPLE ? (size_t)MP + b * 64 + row : (size_t)b * 2048 + t * 64 + row;
        return P.qkv + r * LDQ + (which ? 1024 : 512) + h * 128 + ch * 8; };
    auto kvf32 = [&](int which, int t, int row, int ch) -> const float* { return (which ? P.cdv : P.cdk) + ((size_t)b * 4096 + t * 64 + row) * 512 + h * 128 + ch * 8; };
    {
        u32x4 rk[2], rv[2]; f32x4 fk[SAMPLE ? 4 : 1], fv[SAMPLE ? 4 : 1];
        auto tile_load = [&](int t) {
#pragma unroll
            for (int i = 0; i < 2; ++i) { const int idx = tid + 512 * i, row = idx >> 4, ch = idx & 15;
                if (SAMPLE && t < 64) { const float* pk = kvf32(0, t, row, ch); const float* pv = kvf32(1, t, row, ch);
                    fk[(2 * i) % (SAMPLE ? 4 : 1)] = *(const f32x4*)pk; fk[(2 * i + 1) % (SAMPLE ? 4 : 1)] = *(const f32x4*)(pk + 4); fv[(2 * i) % (SAMPLE ? 4 : 1)] = *(const f32x4*)pv; fv[(2 * i + 1) % (SAMPLE ? 4 : 1)] = *(const f32x4*)(pv + 4); }
                else { rk[i] = *(const u32x4*)kvbf(0, t, row, ch); rv[i] = *(const u32x4*)kvbf(1, t, row, ch); } } };
        auto tile_store = [&](int t, lchar* buf) {
#pragma unroll
            for (int i = 0; i < 2; ++i) { const int idx = tid + 512 * i, row = idx >> 4, ch = idx & 15;
                if (SAMPLE && t < 64) { rk[i] = pack8(fk[(2 * i) % (SAMPLE ? 4 : 1)], fk[(2 * i + 1) % (SAMPLE ? 4 : 1)]); rv[i] = pack8(fv[(2 * i) % (SAMPLE ? 4 : 1)], fv[(2 * i + 1) % (SAMPLE ? 4 : 1)]); }
                *(LAS u32x4*)(buf + offKd(row, ch)) = rk[i]; *(LAS u32x4*)(buf + 16384 + offVd(row, ch)) = rv[i]; } };
        tile_load(0); tile_store(0, lds);
        __syncthreads();
        for (int t = 0; t < ntiles; ++t) {
            const lchar* cur = lds + (t & 1) * DBUF; lchar* nxt = lds + ((t + 1) & 1) * DBUF;
            const bool more = (t + 1 < ntiles);
            if (more) tile_load(t + 1);
            if (SAMPLE) diff_sub(cur, cur + 16384, ksub, map, qf, O, m0, l0, (float)(qpos - t * 64 - ksub * 32 - 4 * hi), sl2, lane);
            else if (t <= tw) {
#pragma unroll
                for (int sub = 0; sub < 2; ++sub) diff_sub(cur, cur + 16384, sub, map, qf, O, m0, l0, (float)(qpos - t * 64 - sub * 32 - 4 * hi), sl2, lane);
            }
            if (more) tile_store(t + 1, nxt);
            __syncthreads();
        }
    }
    if (SAMPLE) {
        LAS float* cb2 = (LAS float*)lds + (wid & 3) * 4224 + lane;
        if (wid >= 4) { cb2[0] = m0; cb2[64] = l0;
#pragma unroll
            for (int d = 0; d < 4; ++d)
#pragma unroll
                for (int r = 0; r < 16; ++r) cb2[(2 + d * 16 + r) * 64] = O[d][r]; }
        __syncthreads();
        if (wid < 4) { const float mP = cb2[0], lP = cb2[64], mm = __builtin_fmaxf(m0, mP);
            const float f = __builtin_amdgcn_exp2f(__builtin_fmaxf(m0 - mm, -200.f)), fP = __builtin_amdgcn_exp2f(__builtin_fmaxf(mP - mm, -200.f));
            l0 = l0 * f + lP * fP; m0 = mm;
#pragma unroll
            for (int d = 0; d < 4; ++d)
#pragma unroll
                for (int r = 0; r < 16; ++r) O[d][r] = O[d][r] * f + cb2[(2 + d * 16 + r) * 64] * fP; }
        __syncthreads();
    }
    l0 += __shfl_xor(l0, 32);
    LAS float* xb = (LAS float*)lds + qg * 4096 + lane;
    if (epi_wave && map == 1) {
        const float i1 = P.lam / l0;
#pragma unroll
        for (int d = 0; d < 4; ++d)
#pragma unroll
            for (int r = 0; r < 16; ++r) xb[(d * 16 + r) * 64] = O[d][r] * i1;
    }
    __syncthreads();
    if (epi_wave && map == 0) {
        const float i0 = 1.0f / l0;
        float ss = 0.f;
#pragma unroll
        for (int d = 0; d < 4; ++d)
#pragma unroll
            for (int r = 0; r < 16; ++r) { const float o = O[d][r] * i0 - xb[(d * 16 + r) * 64]; O[d][r] = o; ss += o * o; }
        ss += __shfl_xor(ss, 32);
        const float rs = __builtin_amdgcn_rsqf(ss * (1.0f / 128.0f) + 1e-6f) * 0.8f;
        bf16_t* orow = P.mixed + qrow_g * 1024 + h * 128;
#pragma unroll
        for (int d = 0; d < 4; ++d)
#pragma unroll
            for (int G = 0; G < 4; ++G) {
                const int d0 = d * 32 + 8 * G + 4 * hi;
                u32x2 w; w.x = cvtpk(O[d][4 * G + 0] * rs * gt[d0 + 0], O[d][4 * G + 1] * rs * gt[d0 + 1]); w.y = cvtpk(O[d][4 * G + 2] * rs * gt[d0 + 2], O[d][4 * G + 3] * rs * gt[d0 + 3]);
                *(u32x2*)(orow + d0) = w;
            }
    }
}

__device__ __forceinline__ void sb_sub(const lchar* Kb, const lchar* Vb, int sub, bool diag, const bf16x8 (&qf)[4], f32x16 (&O)[2], float& R, int lane) {
    const int r32 = lane & 31, hi = lane >> 5;
    f32x16 z = {};
    const int krow = sub * 32 + r32;
    bf16x8 kf[4];
#pragma unroll
    for (int ds = 0; ds < 4; ++ds) kf[ds] = *(const LAS bf16x8*)(Kb + offKs(krow, 2 * ds + hi));
    const int q4 = (lane & 15) >> 2, p = lane & 3, g1 = (lane >> 4) & 1;
    bf16x8 vf[2][2];
#pragma unroll
    for (int s = 0; s < 2; ++s)
#pragma unroll
        for (int d = 0; d < 2; ++d) {
            const int ch = d * 4 + 2 * g1 + (p >> 1);
            const int ra = sub * 32 + 16 * s + 4 * hi + q4, rb = ra + 8;
            vf[s][d] = vfrag(Vb + offVs(ra, ch) + 8 * (p & 1), Vb + offVs(rb, ch) + 8 * (p & 1));
        }
#pragma unroll
    for (int ds = 0; ds < 4; ++ds) z = __builtin_amdgcn_mfma_f32_32x32x16_bf16(kf[ds], qf[ds], z, 0, 0, 0);
    f32x16 lk;
#pragma unroll
    for (int r = 0; r < 16; ++r) {
        const float zc = __builtin_amdgcn_fmed3f(z[r], -200.f, 80.f);
        float l = -__builtin_amdgcn_logf(1.0f + __builtin_amdgcn_exp2f(zc));
        float ls = zc + l;
        if (diag && !(crow(r, hi) < r32)) { l = 0.f; ls = NEG_BIG; }
        lk[r] = l; z[r] = ls;
    }
    float run = R;
#pragma unroll
    for (int G = 3; G >= 0; --G) {
        const float T = (lk[4 * G] + lk[4 * G + 1]) + (lk[4 * G + 2] + lk[4 * G + 3]);
        const float To = __shfl_xor(T, 32);
        const float a3 = run + (hi == 0 ? To : 0.f);
        const float a2 = a3 + lk[4 * G + 3], a1 = a2 + lk[4 * G + 2], a0 = a1 + lk[4 * G + 1];
        z[4 * G + 3] = __builtin_amdgcn_exp2f(__builtin_fmaxf(z[4 * G + 3] + a3, -200.f)); z[4 * G + 2] = __builtin_amdgcn_exp2f(__builtin_fmaxf(z[4 * G + 2] + a2, -200.f));
        z[4 * G + 1] = __builtin_amdgcn_exp2f(__builtin_fmaxf(z[4 * G + 1] + a1, -200.f)); z[4 * G + 0] = __builtin_amdgcn_exp2f(__builtin_fmaxf(z[4 * G + 0] + a0, -200.f));
        run += T + To;
    }
    R = run;
    bf16x8 pf[2]; pf[0] = pfrag(z, 0); pf[1] = pfrag(z, 1);
#pragma unroll
    for (int s = 0; s < 2; ++s)
#pragma unroll
        for (int d = 0; d < 2; ++d) O[d] = __builtin_amdgcn_mfma_f32_32x32x16_bf16(vf[s][d], pf[s], O[d], 0, 0, 0);
}

__device__ __forceinline__ void sb_unit(const bool SAMPLE, lchar* lds, const Params& P, int b, int h, int qb) {
    int tid_ = threadIdx.x; asm volatile("" : "+v"(tid_));
    const int tid = tid_, lane = tid & 63, wid = __builtin_amdgcn_readfirstlane(tid >> 6), r32 = lane & 31, hi = lane >> 5;
    const int q0 = SAMPLE ? 4096 : qb * 256;
    const int wq0 = q0 + (SAMPLE ? (wid & 1) : wid) * 32;
    const size_t qrow_g = SAMPLE ? (size_t)MP + b * 64 + (wid & 1) * 32 + r32 : (size_t)b * 2048 + wq0 + r32;
    const int thi = SAMPLE ? 64 : 4 * qb + 3;
    const int tw = wq0 >> 6, sw = (wq0 >> 5) & 1;
    const bool compute_wave = SAMPLE ? (wid < 2) : true;
    bf16x8 qf[4];
#pragma unroll
    for (int ds = 0; ds < 4; ++ds) qf[ds] = *(const bf16x8*)(P.qkv + qrow_g * LDQ + 1536 + h * 64 + ds * 16 + hi * 8);
    f32x16 O[2]; O[0] = (f32x16){}; O[1] = (f32x16){};
    float R = 0.f;
    auto compute = [&](int t, const lchar* cur) {
        if (t > tw) return;
        if (__all(R < -160.f)) return;
        if (t == tw) {
            if (sw == 1) { sb_sub(cur, cur + 8192, 1, true, qf, O, R, lane); sb_sub(cur, cur + 8192, 0, false, qf, O, R, lane); }
            else sb_sub(cur, cur + 8192, 0, true, qf, O, R, lane);
        } else { sb_sub(cur, cur + 8192, 1, false, qf, O, R, lane); sb_sub(cur, cur + 8192, 0, false, qf, O, R, lane); }
    };
    auto kvload = [&](int which, int t, int row, int ch) -> u32x4 {
        if (SAMPLE && t < 64) return ld_f32x8_bf16((which ? P.csv : P.csk) + ((size_t)b * 4096 + t * 64 + row) * 512 + h * 64 + ch * 8);
        const size_t r = SAMPLE ? (size_t)MP + b * 64 + row : (size_t)b * 2048 + t * 64 + row;
        return *(const u32x4*)(P.qkv + r * LDQ + (which ? 2560 : 2048) + h * 64 + ch * 8); };
    {
        const int row = tid >> 3, ch = tid & 7;
        u32x4 rk = kvload(0, thi, row, ch), rv = kvload(1, thi, row, ch);
        *(LAS u32x4*)(lds + offKs(row, ch)) = rk; *(LAS u32x4*)(lds + 8192 + offVs(row, ch)) = rv;
        __syncthreads();
        int par = 0;
        volatile LAS int* dflag = (volatile LAS int*)(lds + 131072 + 1600);
        for (int t = thi; t >= 0; --t, par ^= 1) {
            const lchar* cur = lds + par * SBUF; lchar* nxt = lds + (par ^ 1) * SBUF;
            if (t > 0) { rk = kvload(0, t - 1, row, ch); rv = kvload(1, t - 1, row, ch); }
            if (compute_wave) compute(t, cur);
            if (t > 0) { *(LAS u32x4*)(nxt + offKs(row, ch)) = rk; *(LAS u32x4*)(nxt + 8192 + offVs(row, ch)) = rv; }
            const int wdone = (!compute_wave || (t <= tw && __all(R < -160.f))) ? 1 : 0;
            if (lane == 0) dflag[par * 8 + wid] = wdone;
            __syncthreads();
            int alld = 1;
#pragma unroll
            for (int w = 0; w < 8; ++w) alld &= dflag[par * 8 + w];
            if (alld) break;
        }
    }
    if (compute_wave) {
        bf16_t* orow = P.mixed + qrow_g * 1024 + 512 + h * 64;
#pragma unroll
        for (int d = 0; d < 2; ++d)
#pragma unroll
            for (int G = 0; G < 4; ++G) {
                const int d0 = d * 32 + 8 * G + 4 * hi;
                u32x2 w; w.x = cvtpk(O[d][4 * G + 0], O[d][4 * G + 1]); w.y = cvtpk(O[d][4 * G + 2], O[d][4 * G + 3]);
                *(u32x2*)(orow + d0) = w;
            }
    }
}

constexpr int N_UNITS = 192 + 8 * 256;
__device__ __forceinline__ void attn_phase(lchar* lds, Params P, const float* subln_g, int u_base, int u_end) {
    LAS float* gt = (LAS float*)(lds + 131072 + 1024);
    volatile LAS int* slot = (volatile LAS int*)(lds + 131072 + 1536);
    if (threadIdx.x < 128) gt[threadIdx.x] = subln_g[threadIdx.x];
    __syncthreads();
    for (;;) {
        if (threadIdx.x == 0) *slot = u_base + (int)atomicAdd(P.queue, 1u);
        __syncthreads();
        const int u = __builtin_amdgcn_readfirstlane(*slot);
        __syncthreads();
        if (u >= u_end) break;
        if (u < 64) { diff_unit<true>(lds, P, gt, u >> 2, u & 3, 0); }
        else if (u < 192) { const int j = u - 64; sb_unit(true, lds, P, j >> 3, j & 7, 0); }
        else {
            const int j = u - 192, g = 7 - (j >> 8), k = j & 255;
            if (k < 128) { diff_unit<false>(lds, P, gt, (k & 63) >> 2, k & 3, 2 * g + 1 - (k >> 6)); }
            else { const int kk = k - 128; sb_unit(false, lds, P, kk >> 3, kk & 7, g); }
        }
    }
}
#undef LAS
}

#define GAS __attribute__((address_space(1)))
#define LAS __attribute__((address_space(3)))
typedef unsigned short bf16;
typedef unsigned v4u __attribute__((ext_vector_type(4)));
typedef float f32x4 __attribute__((ext_vector_type(4)));
constexpr int NWAVES = 8;
constexpr int MT = 33792, MP = 32768, DM = 1024, NIN = 3072, FF = 2816;
constexpr size_t MiB = 1u << 20;
constexpr size_t WS_CTL = 0;
constexpr size_t WS_WIN = 1 * MiB;
constexpr size_t WS_WOUT = 7 * MiB;
constexpr size_t WS_WGU = 9 * MiB;
constexpr size_t WS_WDN = 20 * MiB;
constexpr size_t WS_SSQ1 = 26 * MiB;
constexpr size_t WS_SSQ2 = 29 * MiB;
constexpr size_t WS_XN = 32 * MiB;
constexpr size_t WS_HB = 100 * MiB;
constexpr size_t WS_QKV = 168 * MiB;
constexpr size_t WS_CACHE = 368 * MiB;
constexpr size_t WS_END = 624 * MiB;
constexpr int RING_BYTES = 131072, LDS_BYTES = 147456;

__device__ __forceinline__ unsigned f2bf(float f) { unsigned u = __builtin_bit_cast(unsigned, f); return (u + 0x7fffu + ((u >> 16) & 1u)) >> 16; }
__device__ __forceinline__ unsigned pk2(float lo, float hi) { return f2bf(lo) | (f2bf(hi) << 16); }
__device__ __forceinline__ float wave_sum(float v) {
#pragma unroll
    for (int o = 1; o < 64; o <<= 1) v += __shfl_xor(v, o);
    return v;
}
__device__ __forceinline__ void transpose_item(const float* W, int K, int N, bf16* WT, int k0, int n0, int orow0, const float* kscale, LAS float* scr, int lane) {
#pragma unroll 8
    for (int i = 0; i < 32; ++i) { const int kk = 2 * i + (lane >> 5); float v = W[(size_t)(k0 + kk) * N + n0 + (lane & 31)]; if (kscale) v *= kscale[k0 + kk]; scr[kk * 33 + (lane & 31)] = v; }
    asm volatile("s_waitcnt lgkmcnt(0)" ::: "memory");
    const int c = lane & 7;
#pragma unroll
    for (int j = 0; j < 4; ++j) { const int n = (lane >> 3) + 8 * j; const LAS float* s = scr + (8 * c) * 33 + n;
        v4u o; o.x = pk2(s[0 * 33], s[1 * 33]); o.y = pk2(s[2 * 33], s[3 * 33]); o.z = pk2(s[4 * 33], s[5 * 33]); o.w = pk2(s[6 * 33], s[7 * 33]);
        *(v4u*)(WT + (size_t)(orow0 + n) * K + k0 + 8 * c) = o; }
    asm volatile("s_waitcnt lgkmcnt(0)" ::: "memory");
}

#define XB_TMO      128
#define XB_XCNT(j)  (256  + 64 * (j))
#define XB_XSUB(j)  (1280 + 64 * (j))
#define XB_XGEN(j)  (2304 + 64 * (j))
#define XB_TOP      3328
#define XB_TOPGEN   3392
#define XCD_BAR_WORDS 3456
#define XB_SPIN_CAP (1u << 18)

__device__ __forceinline__ unsigned xb_ld(unsigned* p)              { return __hip_atomic_load(p, __ATOMIC_RELAXED, __HIP_MEMORY_SCOPE_AGENT); }
__device__ __forceinline__ unsigned xb_add(unsigned* p, unsigned v) { return __hip_atomic_fetch_add(p, v, __ATOMIC_RELAXED, __HIP_MEMORY_SCOPE_AGENT); }
__device__ __forceinline__ unsigned xb_xcc_id() { return (unsigned)__builtin_amdgcn_s_getreg((3 << 11) | 20) & 0xFu; }
#define XB_SPIN(cond, bar) do { unsigned _sp = 0; while (cond) { __builtin_amdgcn_s_sleep(1); \
    if ((++_sp & 255u) == 0u) { if (xb_ld(&(bar)[XB_TMO])) break; if (_sp > XB_SPIN_CAP) { atomicAdd(&(bar)[XB_TMO], 1u); break; } } } } while (0)

struct XcdBarrier {
    unsigned* bar; unsigned x;
    volatile LAS unsigned* st;
};

__device__ __forceinline__ XcdBarrier xcd_barrier_post(unsigned* bar, volatile LAS unsigned* st) {
    XcdBarrier b; b.bar = bar; b.x = xb_xcc_id(); b.st = st;
    if (threadIdx.x == 0) (void)xb_add(&bar[XB_XCNT(b.x)], 1u);
    return b;
}
__device__ __forceinline__ void xcd_barrier_complete(unsigned* bar, unsigned x, unsigned& nloc, unsigned& nx) {
    const unsigned G = gridDim.x * gridDim.y * gridDim.z;
    unsigned sum, cnt, mine, sp = 0u;
    for (;;) {
        sum = 0u; cnt = 0u; mine = 0u;
#pragma unroll
        for (unsigned j = 0; j < 16; ++j) { const unsigned c = xb_ld(&bar[XB_XCNT(j)]); sum += c; cnt += (c > 0u) ? 1u : 0u; mine = (j == x) ? c : mine; }
        if (sum == G) break;
        __builtin_amdgcn_s_sleep(1);
        if ((++sp & 255u) == 0u) { if (xb_ld(&bar[XB_TMO])) break; if (sp > XB_SPIN_CAP) { atomicAdd(&bar[XB_TMO], 1u); break; } }
    }
    nloc = mine > 0u ? mine : 1u; nx = cnt > 0u ? cnt : 1u;
}

__device__ __forceinline__ void xcd_barrier(const XcdBarrier& b) {
    asm volatile("s_waitcnt vmcnt(0)" ::: "memory");
    __syncthreads();
    if (threadIdx.x == 0) {
        unsigned* bar = b.bar;
        __builtin_amdgcn_s_waitcnt(0);
        unsigned nloc = b.st[0], nx = b.st[1];
        if (nloc == 0u) { xcd_barrier_complete(bar, b.x, nloc, nx); b.st[0] = nloc; b.st[1] = nx; }
        const unsigned old = xb_add(&bar[XB_XSUB(b.x)], 1u);
        const unsigned gen = old / nloc;
        if (old + 1u == (gen + 1u) * nloc) {
            __builtin_amdgcn_fence(__ATOMIC_RELEASE, "agent");
            asm volatile("s_waitcnt vmcnt(0)" ::: "memory");
            const unsigned og = xb_add(&bar[XB_TOP], 1u);
            const unsigned tg = og / nx;
            if (og + 1u == (tg + 1u) * nx) xb_add(&bar[XB_TOPGEN], 1u);
            else XB_SPIN(xb_ld(&bar[XB_TOPGEN]) == tg, bar);
            __builtin_amdgcn_fence(__ATOMIC_ACQUIRE, "agent");
            xb_add(&bar[XB_XGEN(b.x)], 1u);
            asm volatile("s_waitcnt vmcnt(0)" ::: "memory");
        } else {
            XB_SPIN(xb_ld(&bar[XB_XGEN(b.x)]) == gen, bar);
            __builtin_amdgcn_fence(__ATOMIC_ACQUIRE, "agent");
            asm volatile("s_waitcnt vmcnt(0)" ::: "memory");
        }
    }
    __syncthreads();
}


struct Args {
    const float* in[19]; float* out; unsigned char* ws; int ph_lo, ph_hi; int isz[20];
};

__global__ void __launch_bounds__(NWAVES * 64, 2) fwd_kernel(Args args) {
    extern __shared__ __attribute__((aligned(16))) unsigned char lds_raw[];
    LAS unsigned char* lds = (LAS unsigned char*)lds_raw;
    const int tid = threadIdx.x, lane = tid & 63, wave = __builtin_amdgcn_readfirstlane(tid >> 6);
    const int G = gridDim.x;
    unsigned char* ws = args.ws;
    const float* xp = args.in[0]; const float* xs = args.in[1];
    float* out = args.out;
    bf16* Win_t = (bf16*)(ws + WS_WIN); bf16* Wout_t = (bf16*)(ws + WS_WOUT); bf16* Wgu_t = (bf16*)(ws + WS_WGU); bf16* Wdn_t = (bf16*)(ws + WS_WDN);
    bf16* XN = (bf16*)(ws + WS_XN); bf16* HB = (bf16*)(ws + WS_HB); bf16* QKV = (bf16*)(ws + WS_QKV); bf16* ACT = (bf16*)(ws + WS_QKV);
    float* SSQ1 = (float*)(ws + WS_SSQ1); float* SSQ2 = (float*)(ws + WS_SSQ2);
    const int lo = args.ph_lo, hi = args.ph_hi;
#define IN(k) (lo <= (k) && (k) < hi)
    unsigned* barw = (unsigned*)(ws + WS_CTL) + 1024;
    volatile LAS unsigned* MISC = (volatile LAS unsigned*)(lds + 131072 + 320);
    XcdBarrier xbar; xbar.bar = barw; xbar.x = 0; xbar.st = MISC + 8;
#define SEAM(k) do { if (IN(k) && IN((k) + 1)) { \
        if ((k) == 0) { asm volatile("s_waitcnt vmcnt(0)" ::: "memory"); cg::this_grid().sync(); if (tid == 0) { MISC[8] = 0u; MISC[9] = 0u; } __syncthreads(); xbar = xcd_barrier_post(barw, MISC + 8); } \
        else xcd_barrier(xbar); } } while (0)

    if (IN(0)) {
        if (blockIdx.x == 0 && tid == 0) { __hip_atomic_store((unsigned*)(ws + WS_CTL), 0u, __ATOMIC_RELAXED, __HIP_MEMORY_SCOPE_AGENT); __hip_atomic_store((unsigned*)(ws + WS_CTL) + 64, 0u, __ATOMIC_RELAXED, __HIP_MEMORY_SCOPE_AGENT); }
        if (blockIdx.x == 0) for (int i = tid; i < XCD_BAR_WORDS; i += 512) __hip_atomic_store(barw + i, 0u, __ATOMIC_RELAXED, __HIP_MEMORY_SCOPE_AGENT);
        LAS float* scr = (LAS float*)(lds + wave * 16384);
        const int gw = blockIdx.x * NWAVES + wave, NGW = G * NWAVES;
        constexpr int I_IN = 16 * 96, I_OUT = 16 * 32, I_G = 16 * 88, I_D = 44 * 32;
        constexpr int NITEMS = I_IN + I_OUT + 2 * I_G + I_D;
        const float* w_in = args.in[7]; const float* w_out = args.in[13]; const float* g_ffn = args.in[14];
        const float* w_gate = args.in[15]; const float* w_up = args.in[16]; const float* w_down = args.in[17];
        for (int it = gw; it < NITEMS; it += NGW) {
            int r = it;
            if (r < I_IN) { const int kb = r / 96, nb = r % 96; transpose_item(w_in, DM, NIN, Win_t, 64 * kb, 32 * nb, 32 * nb, nullptr, scr, lane); continue; } r -= I_IN;
            if (r < I_OUT) { const int kb = r / 32, nb = r % 32; transpose_item(w_out, DM, DM, Wout_t, 64 * kb, 32 * nb, 32 * nb, nullptr, scr, lane); continue; } r -= I_OUT;
            if (r < I_G) { const int kb = r / 88, nb = r % 88, n0 = 32 * nb; transpose_item(w_gate, DM, FF, Wgu_t, 64 * kb, n0, 256 * (n0 >> 7) + (n0 & 127), g_ffn, scr, lane); continue; } r -= I_G;
            if (r < I_G) { const int kb = r / 88, nb = r % 88, n0 = 32 * nb; transpose_item(w_up, DM, FF, Wgu_t, 64 * kb, n0, 256 * (n0 >> 7) + 128 + (n0 & 127), g_ffn, scr, lane); continue; } r -= I_G;
            { const int kb = r / 32, nb = r % 32; transpose_item(w_down, FF, DM, Wdn_t, 64 * kb, 32 * nb, 32 * nb, nullptr, scr, lane); }
        }
        const float* g_attn = args.in[6];
        f32x4 gv[4];
#pragma unroll
        for (int j = 0; j < 4; ++j) gv[j] = ((const f32x4*)g_attn)[lane + 64 * j];
        for (int m = gw; m < MT; m += NGW) {
            const float* xrow = (m < MP) ? xp + (size_t)m * DM : xs + (size_t)(m - MP) * DM;
            const f32x4* xr = (const f32x4*)xrow + lane;
            f32x4 v[4]; float s = 0.f;
#pragma unroll
            for (int j = 0; j < 4; ++j) { v[j] = xr[64 * j]; s += (v[j].x * v[j].x + v[j].y * v[j].y) + (v[j].z * v[j].z + v[j].w * v[j].w); }
            const float rstd = __builtin_amdgcn_rsqf(wave_sum(s) * (1.f / DM) + 1e-6f);
            unsigned long long* o8 = (unsigned long long*)(XN + (size_t)m * DM) + lane;
#pragma unroll
            for (int j = 0; j < 4; ++j) { const f32x4 w = v[j] * rstd * gv[j]; o8[64 * j] = (unsigned long long)pk2(w.x, w.y) | ((unsigned long long)pk2(w.z, w.w) << 32); }
        }
    }
    SEAM(0);

    if (IN(1)) {
        pg8::Gemm g{XN, Win_t, MT, NIN, DM}; pg8::StaticOrder S; S.init(MT, NIN, G, (int)blockIdx.x);
        pg8::EpiQKV E{QKV, out, att::C2};
        pg8::gemm_phase<pg8::EpiQKV, pg8::StaticOrder, true, true>(lds, g, S, E);
    }
    SEAM(1);

    if (IN(2)) {
        const float d1 = wave_sum(args.in[8][lane] * args.in[9][lane]), d2 = wave_sum(args.in[10][lane] * args.in[11][lane]);
        att::Params P;
        P.qkv = QKV; P.cdk = args.in[2]; P.cdv = args.in[3]; P.csk = args.in[4]; P.csv = args.in[5]; P.mixed = XN; P.queue = (unsigned*)(ws + WS_CTL);
        P.lam = __expf(d1) - __expf(d2) + 0.2f;
        att::attn_phase(lds, P, args.in[12], 0, att::N_UNITS);
    }
    SEAM(2);

    if (IN(3)) {
        pg8::Gemm g{XN, Wout_t, MT, DM, DM};
        pg8::StaticOrder S; S.init(MT, DM, G, (int)blockIdx.x);
        pg8::EpiRes E{xp, xs, out, HB, SSQ1};
        pg8::gemm_phase<pg8::EpiRes, pg8::StaticOrder, true, true>(lds, g, S, E);
    }
    SEAM(3);

    if (IN(4)) {
        pg8::Gemm g{HB, Wgu_t, MT, 2 * FF, DM}; pg8::StaticOrder S; S.init(MT, 2 * FF, G, (int)blockIdx.x);
        pg8::EpiSwiGLU E{ACT, SSQ1};
        pg8::gemm_phase<pg8::EpiSwiGLU, pg8::StaticOrder, true, true>(lds, g, S, E);
    }
    SEAM(4);

    if (IN(5)) {
        pg8::Gemm g{ACT, Wdn_t, MT, DM, FF}; pg8::StaticOrder S; S.init(MT, DM, G, (int)blockIdx.x);
        pg8::EpiRes E{out, out + (size_t)MP * DM, out, nullptr, SSQ2};
        pg8::gemm_phase<pg8::EpiRes, pg8::StaticOrder, true, true>(lds, g, S, E);
    }
    SEAM(5);

    if (IN(6)) {
        const int gw = blockIdx.x * NWAVES + wave, NGW = G * NWAVES;
        const float* g_fin = args.in[18];
        f32x4 gv[4];
#pragma unroll
        for (int j = 0; j < 4; ++j) gv[j] = ((const f32x4*)g_fin)[lane + 64 * j];
        for (int m = gw; m < MT; m += 2 * NGW) {
            const int m2 = m + NGW; const bool has2 = m2 < MT; const int mb = has2 ? m2 : m;
            const float pa = (lane < 16) ? SSQ2[((size_t)(lane >> 2) * MT + m) * 4 + (lane & 3)] : 0.f;
            const float pb = (lane < 16) ? SSQ2[((size_t)(lane >> 2) * MT + mb) * 4 + (lane & 3)] : 0.f;
            f32x4* ya = (f32x4*)(out + (size_t)m * DM) + lane; f32x4* yb = (f32x4*)(out + (size_t)mb * DM) + lane;
            f32x4 va[4], vb[4];
#pragma unroll
            for (int j = 0; j < 4; ++j) { va[j] = ya[64 * j]; vb[j] = yb[64 * j]; }
            const float ra = __builtin_amdgcn_rsqf(wave_sum(pa) * (1.f / DM) + 1e-6f), rb = __builtin_amdgcn_rsqf(wave_sum(pb) * (1.f / DM) + 1e-6f);
#pragma unroll
            for (int j = 0; j < 4; ++j) ya[64 * j] = va[j] * ra * gv[j];
            if (has2) {
#pragma unroll
                for (int j = 0; j < 4; ++j) yb[64 * j] = vb[j] * rb * gv[j];
            }
        }
    }
#undef IN
#undef SEAM
}

#ifndef MK_N_LAUNCHES
#define MK_N_LAUNCHES 1
#endif
extern "C" void kernel_launch(void* const* d_in, const int* in_sizes, int n_in, void* d_out, int out_size, void* d_ws, size_t ws_size, hipStream_t stream) {
    static int grid = 0;
    if (grid == 0) {
        if (n_in != 19 || ws_size < WS_END) { fprintf(stderr, "kernel_launch: unexpected n_in %d or ws_size %zu\n", n_in, ws_size); grid = -1; return; }
        int dev = 0, cus = 0, per_cu = 0;
        hipGetDevice(&dev); hipDeviceGetAttribute(&cus, hipDeviceAttributeMultiprocessorCount, dev);
        hipFuncSetAttribute((const void*)fwd_kernel, hipFuncAttributeMaxDynamicSharedMemorySize, LDS_BYTES);
        hipOccupancyMaxActiveBlocksPerMultiprocessor(&per_cu, (const void*)fwd_kernel, NWAVES * 64, LDS_BYTES);
        if (per_cu < 1) { fprintf(stderr, "kernel_launch: occupancy query says %d blocks per CU\n", per_cu); per_cu = 1; }
        (void)hipGetLastError();
        grid = cus * per_cu;
    }
    if (grid < 0) return;
    Args a{};
    for (int i = 0; i < 19; ++i) a.in[i] = (const float*)d_in[i];
    a.out = (float*)d_out; a.ws = (unsigned char*)d_ws; for (int i = 0; i < 19; ++i) a.isz[i] = in_sizes[i];
    if (MK_N_LAUNCHES == 1) {
        a.ph_lo = 0; a.ph_hi = 7;
        void* kargs[] = {&a};
        hipError_t e = hipLaunchCooperativeKernel((const void*)fwd_kernel, dim3(grid), dim3(NWAVES * 64), kargs, LDS_BYTES, stream);
        if (e != hipSuccess) fprintf(stderr, "cooperative launch failed: %s (grid %d)\n", hipGetErrorString(e), grid);
    } else {
        for (int ph = 0; ph < 7; ++ph) { a.ph_lo = ph; a.ph_hi = ph + 1; hipLaunchKernelGGL(fwd_kernel, dim3(grid), dim3(NWAVES * 64), LDS_BYTES, stream, a); }
    }
}
```

```cpp
#include <hip/hip_runtime.h>
#include <hip/hip_cooperative_groups.h>
#include <cstdio>
#include <cstdint>
namespace cg = cooperative_groups;
namespace pg8 {
#define PG8_LAS __attribute__((address_space(3)))
typedef unsigned short bf16_t;
typedef short bf16x8 __attribute__((ext_vector_type(8)));
typedef float f32x4 __attribute__((ext_vector_type(4)));
typedef unsigned u32x4 __attribute__((ext_vector_type(4)));
constexpr int BM = 256, BK = 64, HALF = 128, HTB = HALF * BK * 2  , STAGE_BYTES = 8 * HTB, NXCD = 8, WGM = 8;

__host__ __device__ __forceinline__ int lds_byte(int r, int c) { const int st = (r >> 4) * 2 + (c >> 5), rr = r & 15, cc = c & 31, ob = rr * 64 + cc * 2; return st * 1024 + (ob ^ (((ob >> 9) & 1) << 5)); }
__host__ __device__ __forceinline__ void stage_rc(int b, int& R, int& C) { const int st = b / 1024, sb = b % 1024, swz = sb ^ (((sb >> 9) & 1) << 5); R = (st >> 1) * 16 + swz / 64; C = (st & 1) * 32 + (swz % 64) / 2; }
__host__ __device__ __forceinline__ int perm32(int rho) { const int n = rho >> 4, i = rho & 15; return 8 * (i >> 2) + 4 * n + (i & 3); }

struct Unit { int pm, pn; };
struct Gemm { const bf16_t* A; const bf16_t* Bt; int M, N, K; };

struct StaticOrder {
    int nM, nN, nwg, G, c;
    __host__ __device__ void init(int M, int N, int G_, int c_) { nM = M / BM; nN = N / BM; nwg = nM * nN; G = G_; c = c_; }
    __host__ __device__ bool next(int i, Unit& u) const {
        const long L = (long)i * G + c; if (L >= nwg) return false;
        int wgid = (int)L; { const int q = nwg / NXCD, r = nwg % NXCD, xcd = wgid % NXCD, off = wgid / NXCD; wgid = (xcd < r ? xcd * (q + 1) : r * (q + 1) + (xcd - r) * q) + off; }
        const int nig = WGM * nN, gid = wgid / nig, fm = gid * WGM, gsz = (nM - fm) < WGM ? (nM - fm) : WGM;
        u.pm = fm + ((wgid % nig) % gsz); u.pn = (wgid % nig) / gsz; return true;
    }
    __device__ __forceinline__ void a_ready(const Unit&) const {}
    __device__ __forceinline__ void done(const Unit&) const {}
};

__device__ __forceinline__ unsigned cvt_pk_bf16(float lo, float hi) { unsigned r; asm volatile("v_cvt_pk_bf16_f32 %0, %1, %2" : "=v"(r) : "v"(lo), "v"(hi)); return r; }
typedef float f32x2 __attribute__((ext_vector_type(2)));

constexpr int MT = 33792;
constexpr int MP = 32768;
constexpr size_t OFF_PKV = (size_t)MT * 1024;
constexpr size_t OFF_SKV = OFF_PKV + 4ull * MP * 512;
constexpr float RMS_EPS = 1e-6f;
constexpr float LOG2E = 1.4426950408889634f;
typedef float f32x2 __attribute__((ext_vector_type(2)));

struct EpiQKV {
    static constexpr bool PERM = true, AFTER_DRAIN = false;
    bf16_t* qkv; float* out; float qscale;
    __device__ __forceinline__ void operator()(const f32x4 (&acc)[2][2][4][2], const Unit& u, int wr, int wc, int fr, int fq) const {
        const int seg = u.pn >> 1;
        const bool isq = (seg == 0) || (seg == 3);
        const float sc = isq ? qscale : 1.f;
        const int row0 = u.pm * BM + wr * 64 + fr, col0 = u.pn * BM + wc * 32 + 8 * fq;
        const int oi = (seg == 1) ? 0 : (seg == 2) ? 1 : (seg == 4) ? 2 : 3;
        const bool prompt = u.pm < (MP / BM);
        float* obase = prompt ? out + OFF_PKV + (size_t)oi * ((size_t)MP * 512) : out + OFF_SKV + (size_t)oi * (1024 * 512);
        const int orow0 = prompt ? row0 : row0 - MP;
        const int ocol0 = (u.pn & 1) * 256 + wc * 32 + 8 * fq;
#pragma unroll
        for (int ai = 0; ai < 2; ++ai)
#pragma unroll
            for (int m = 0; m < 4; ++m) {
                const int rr = ai * HALF + m * 16;
#pragma unroll
                for (int bj = 0; bj < 2; ++bj) {
                    const f32x4 v0 = acc[ai][bj][m][0], v1 = acc[ai][bj][m][1];
                    if (!isq) { float* op = obase + (size_t)(orow0 + rr) * 512 + ocol0 + bj * HALF; *(f32x4*)op = v0; *(f32x4*)(op + 4) = v1; }
                    u32x4 w; w.x = cvt_pk_bf16(v0[0] * sc, v0[1] * sc); w.y = cvt_pk_bf16(v0[2] * sc, v0[3] * sc); w.z = cvt_pk_bf16(v1[0] * sc, v1[1] * sc); w.w = cvt_pk_bf16(v1[2] * sc, v1[3] * sc);
                    *(u32x4*)(qkv + (size_t)(row0 + rr) * 3072 + col0 + bj * HALF) = w;
                }
            }
    }
};

struct EpiRes {
    static constexpr bool PERM = true, AFTER_DRAIN = false;
    const float* bp; const float* bs; float* Y; bf16_t* hb; float* ssq;
    __device__ __forceinline__ void operator()(const f32x4 (&acc)[2][2][4][2], const Unit& u, int wr, int wc, int fr, int fq) const {
        const int row0 = u.pm * BM + wr * 64 + fr, col0 = u.pn * BM + wc * 32 + 8 * fq;
        const bool prompt = u.pm < (MP / BM);
#pragma unroll
        for (int ai = 0; ai < 2; ++ai)
#pragma unroll
            for (int m = 0; m < 4; ++m) {
                const int row = row0 + ai * HALF + m * 16;
                const float* b = prompt ? bp + (size_t)row * 1024 : bs + (size_t)(row - MP) * 1024;
                float s = 0.f;
#pragma unroll
                for (int bj = 0; bj < 2; ++bj) {
                    const int col = col0 + bj * HALF;
                    const f32x4 v0 = acc[ai][bj][m][0] + *(const f32x4*)(b + col), v1 = acc[ai][bj][m][1] + *(const f32x4*)(b + col + 4);
                    float* yp = Y + (size_t)row * 1024 + col; *(f32x4*)yp = v0; *(f32x4*)(yp + 4) = v1;
                    if (hb) { u32x4 w; w.x = cvt_pk_bf16(v0[0], v0[1]); w.y = cvt_pk_bf16(v0[2], v0[3]); w.z = cvt_pk_bf16(v1[0], v1[1]); w.w = cvt_pk_bf16(v1[2], v1[3]);
                        *(u32x4*)(hb + (size_t)row * 1024 + col) = w; }
                    s += (v0[0] * v0[0] + v0[1] * v0[1]) + (v0[2] * v0[2] + v0[3] * v0[3]) + (v1[0] * v1[0] + v1[1] * v1[1]) + (v1[2] * v1[2] + v1[3] * v1[3]);
                }
                s += __shfl_xor(s, 16); s += __shfl_xor(s, 32);
                if (fq == 0) ssq[((size_t)u.pn * MT + row) * 4 + wc] = s;
            }
    }
};

struct EpiSwiGLU {
    static constexpr bool PERM = true, AFTER_DRAIN = false;
    bf16_t* act; const float* ssq;
    __device__ __forceinline__ void operator()(const f32x4 (&acc)[2][2][4][2], const Unit& u, int wr, int wc, int fr, int fq) const {
        const int row0 = u.pm * BM + wr * 64 + fr, col0 = u.pn * HALF + wc * 32 + 8 * fq;
#pragma unroll
        for (int ai = 0; ai < 2; ++ai)
#pragma unroll
            for (int m = 0; m < 4; ++m) {
                const int row = row0 + ai * HALF + m * 16;
                const f32x4 a = *(const f32x4*)(ssq + (size_t)row * 4), b = *(const f32x4*)(ssq + ((size_t)MT + row) * 4), c = *(const f32x4*)(ssq + ((size_t)2 * MT + row) * 4), d = *(const f32x4*)(ssq + ((size_t)3 * MT + row) * 4);
                const float tot = ((a[0] + a[1]) + (a[2] + a[3])) + ((b[0] + b[1]) + (b[2] + b[3])) + ((c[0] + c[1]) + (c[2] + c[3])) + ((d[0] + d[1]) + (d[2] + d[3]));
                const float rstd = __builtin_amdgcn_rsqf(tot * (1.0f / 1024.0f) + RMS_EPS);
                float o[8];
#pragma unroll
                for (int n = 0; n < 2; ++n)
#pragma unroll
                    for (int i = 0; i < 4; ++i) {
                        const float g = acc[ai][0][m][n][i] * rstd, up = acc[ai][1][m][n][i] * rstd;
                        o[n * 4 + i] = g * __builtin_amdgcn_rcpf(1.f + __builtin_amdgcn_exp2f(__builtin_fmaxf(-g * LOG2E, -126.f))) * up;
                    }
                u32x4 w; w.x = cvt_pk_bf16(o[0], o[1]); w.y = cvt_pk_bf16(o[2], o[3]); w.z = cvt_pk_bf16(o[4], o[5]); w.w = cvt_pk_bf16(o[6], o[7]);
                *(u32x4*)(act + (size_t)row * 2816 + col0) = w;
            }
    }
};
template <class Epi, class Sched, bool ALIGN_EPI = false, bool SP2 = false>
__device__ __forceinline__ void gemm_phase(PG8_LAS unsigned char* lds, const Gemm g, const Sched& S, const Epi& E) {
    const int tid = threadIdx.x, wid = __builtin_amdgcn_readfirstlane(tid >> 6), lane = tid & 63, wr = wid >> 2, wc = wid & 3, fr = lane & 15, fq = lane >> 4;
    const int K = g.K, nt = K / BK;
    unsigned voffA[2], voffB[2];
#pragma unroll
    for (int i = 0; i < 2; ++i) { int R, C; stage_rc(tid * 16 + i * 8192, R, C); const int Rb = Epi::PERM ? ((R & ~31) + perm32(R & 31)) : R;
        voffA[i] = (unsigned)(R * K + C) * 2u; voffB[i] = (unsigned)(Rb * K + C) * 2u; }
    const size_t kstep = (size_t)(BK * 2);
    const size_t hstep = (size_t)HALF * K * 2;
    const size_t tstep = 2 * hstep;
    const unsigned ldsw = (unsigned)wid * 1024u;
    const int aoff = lds_byte(wr * 64 + fr, fq * 8), boff = lds_byte(wc * 32 + fr, fq * 8);
#define PG8_SA(b, h) (((b) * 2 + (h)) * HTB)
#define PG8_SB(b, h) ((4 + (b) * 2 + (h)) * HTB)
#define PG8_STAGE(bufoff, gbase, voff) do { _Pragma("unroll") for (int _i = 0; _i < 2; ++_i) \
        __builtin_amdgcn_global_load_lds((const unsigned*)((const char*)(gbase) + (voff)[_i]), (PG8_LAS unsigned*)(lds + (bufoff) + ldsw + _i * 8192), 16, 0, 0); } while (0)
#define PG8_LDA(dst, b, h) do { _Pragma("unroll") for (int m = 0; m < 4; ++m) _Pragma("unroll") for (int k = 0; k < 2; ++k) dst[m][k] = *(const PG8_LAS bf16x8*)(lds + PG8_SA(b, h) + aoff + m * 2048 + k * 1024); } while (0)
#define PG8_LDB(dst, b, h) do { _Pragma("unroll") for (int n = 0; n < 2; ++n) _Pragma("unroll") for (int k = 0; k < 2; ++k) dst[n][k] = *(const PG8_LAS bf16x8*)(lds + PG8_SB(b, h) + boff + n * 2048 + k * 1024); } while (0)
#define PG8_MMA(ai, bj, At, Bt) do { __builtin_amdgcn_s_setprio(1); _Pragma("unroll") for (int m = 0; m < 4; ++m) _Pragma("unroll") for (int n = 0; n < 2; ++n) _Pragma("unroll") for (int k = 0; k < 2; ++k) \
        acc[ai][bj][m][n] = __builtin_amdgcn_mfma_f32_16x16x32_bf16(Bt[n][k], At[m][k], acc[ai][bj][m][n], 0, 0, 0); __builtin_amdgcn_s_setprio(0); } while (0)
#define PG8_WAIT_V(n) asm volatile("s_waitcnt vmcnt(" #n ")" ::: "memory")
#define PG8_WAIT_L(n) asm volatile("s_waitcnt lgkmcnt(" #n ")" ::: "memory")
#define PG8_BAR __builtin_amdgcn_s_barrier()
#define PG8_SCHED __builtin_amdgcn_sched_barrier(0)
    Unit cur, nxt; int ui = 0;
    if (!S.next(0, cur)) return;
    f32x4 acc[2][2][4][2];
#pragma unroll
    for (int a = 0; a < 2; ++a)
#pragma unroll
        for (int b = 0; b < 2; ++b)
#pragma unroll
            for (int m = 0; m < 4; ++m)
#pragma unroll
                for (int n = 0; n < 2; ++n) acc[a][b][m][n] = (f32x4){0.f, 0.f, 0.f, 0.f};
    bf16x8 At[4][2], B0[2][2], B1[2][2];
    const char* cA = (const char*)g.A + (size_t)cur.pm * tstep; const char* cB = (const char*)g.Bt + (size_t)cur.pn * tstep;
    S.a_ready(cur);
    if constexpr (SP2) {
        PG8_STAGE(PG8_SB(0, 0), cB, voffB); PG8_STAGE(PG8_SB(0, 1), cB + hstep, voffB); PG8_STAGE(PG8_SA(0, 0), cA, voffA); PG8_STAGE(PG8_SA(0, 1), cA + hstep, voffA);
        if (wr == 1) PG8_BAR;
        PG8_WAIT_V(2); PG8_BAR;
        PG8_STAGE(PG8_SB(1, 0), cB + kstep, voffB); PG8_STAGE(PG8_SA(1, 0), cA + kstep, voffA); PG8_STAGE(PG8_SB(1, 1), cB + hstep + kstep, voffB);
        PG8_WAIT_V(6); PG8_BAR;
    } else {
        PG8_STAGE(PG8_SB(0, 0), cB, voffB); PG8_STAGE(PG8_SA(0, 0), cA, voffA); PG8_STAGE(PG8_SB(0, 1), cB + hstep, voffB); PG8_STAGE(PG8_SA(0, 1), cA + hstep, voffA);
        if (wr == 1) PG8_BAR;
        PG8_WAIT_V(4); PG8_BAR;
        PG8_STAGE(PG8_SB(1, 0), cB + kstep, voffB); PG8_STAGE(PG8_SA(1, 0), cA + kstep, voffA); PG8_STAGE(PG8_SB(1, 1), cB + hstep + kstep, voffB);
        PG8_WAIT_V(6); PG8_BAR;
    }
    for (;;) {
        const bool has_next = S.next(ui + 1, nxt);
        const char* nA = has_next ? (const char*)g.A + (size_t)nxt.pm * tstep : cA; const char* nB = has_next ? (const char*)g.Bt + (size_t)nxt.pn * tstep : cB;
        for (int t = 0; t < nt; t += 2) {
            const bool last = (t == nt - 2);
            const char* a1 = cA + (size_t)(t + 1) * kstep;
            const char* a2 = last ? nA : cA + (size_t)(t + 2) * kstep; const char* b2 = last ? nB : cB + (size_t)(t + 2) * kstep;
            const char* a3 = a2 + kstep; const char* b3 = b2 + kstep;
            if (last && has_next) S.a_ready(nxt);
            if constexpr (SP2) {
            PG8_LDB(B0, 0, 0); PG8_LDB(B1, 0, 1); PG8_SCHED; PG8_LDA(At, 0, 0); PG8_STAGE(PG8_SA(1, 1), a1 + hstep, voffA);
            PG8_WAIT_V(8); PG8_WAIT_L(0); PG8_BAR; PG8_MMA(0, 0, At, B0); PG8_MMA(0, 1, At, B1); PG8_BAR; PG8_SCHED;
            PG8_LDA(At, 0, 1); PG8_STAGE(PG8_SB(0, 0), b2, voffB); PG8_STAGE(PG8_SB(0, 1), b2 + hstep, voffB); PG8_STAGE(PG8_SA(0, 0), a2, voffA);
            PG8_WAIT_V(8); PG8_WAIT_L(0); PG8_BAR; PG8_MMA(1, 0, At, B0); PG8_MMA(1, 1, At, B1); PG8_BAR; PG8_SCHED;
            PG8_LDB(B0, 1, 0); PG8_LDB(B1, 1, 1); PG8_SCHED; PG8_LDA(At, 1, 0); PG8_STAGE(PG8_SA(0, 1), a2 + hstep, voffA);
            PG8_WAIT_V(8); PG8_WAIT_L(0); PG8_BAR; PG8_MMA(0, 0, At, B0); PG8_MMA(0, 1, At, B1); PG8_BAR; PG8_SCHED;
            PG8_LDA(At, 1, 1); PG8_STAGE(PG8_SB(1, 0), b3, voffB); PG8_STAGE(PG8_SB(1, 1), b3 + hstep, voffB); PG8_STAGE(PG8_SA(1, 0), a3, voffA);
            PG8_WAIT_V(8); PG8_WAIT_L(0); PG8_BAR; PG8_MMA(1, 0, At, B0); PG8_MMA(1, 1, At, B1); PG8_BAR; PG8_SCHED;
            } else {
            PG8_LDB(B0, 0, 0); PG8_SCHED; PG8_LDA(At, 0, 0); PG8_STAGE(PG8_SA(1, 1), a1 + hstep, voffA);
            PG8_WAIT_L(8); PG8_BAR; PG8_WAIT_L(0); PG8_MMA(0, 0, At, B0); PG8_BAR; PG8_SCHED;
            PG8_LDB(B1, 0, 1); PG8_STAGE(PG8_SB(0, 0), b2, voffB);
            PG8_BAR; PG8_WAIT_L(0); PG8_MMA(0, 1, At, B1); PG8_BAR;
            PG8_LDA(At, 0, 1); PG8_STAGE(PG8_SA(0, 0), a2, voffA);
            PG8_BAR; PG8_WAIT_L(0); PG8_MMA(1, 0, At, B0); PG8_BAR; PG8_SCHED;
            PG8_STAGE(PG8_SB(0, 1), b2 + hstep, voffB);
            PG8_WAIT_V(6); PG8_BAR; PG8_MMA(1, 1, At, B1); PG8_BAR;
            PG8_LDB(B0, 1, 0); PG8_SCHED; PG8_LDA(At, 1, 0); PG8_STAGE(PG8_SA(0, 1), a2 + hstep, voffA);
            PG8_WAIT_L(8); PG8_BAR; PG8_WAIT_L(0); PG8_MMA(0, 0, At, B0); PG8_BAR; PG8_SCHED;
            PG8_LDB(B1, 1, 1); PG8_STAGE(PG8_SB(1, 0), b3, voffB);
            PG8_BAR; PG8_WAIT_L(0); PG8_MMA(0, 1, At, B1); PG8_BAR;
            PG8_LDA(At, 1, 1); PG8_STAGE(PG8_SA(1, 0), a3, voffA);
            PG8_BAR; PG8_WAIT_L(0); PG8_MMA(1, 0, At, B0); PG8_BAR; PG8_SCHED;
            PG8_STAGE(PG8_SB(1, 1), b3 + hstep, voffB);
            PG8_WAIT_V(6); PG8_BAR; PG8_MMA(1, 1, At, B1); PG8_BAR;
            }
        }
        if constexpr (ALIGN_EPI) { if (wr == 0) PG8_BAR; }
        if constexpr (!Epi::AFTER_DRAIN) { E(acc, cur, wr, wc, fr, fq); S.done(cur); }
        if (!has_next) break;
#pragma unroll
        for (int a = 0; a < 2; ++a)
#pragma unroll
            for (int b = 0; b < 2; ++b)
#pragma unroll
                for (int m = 0; m < 4; ++m)
#pragma unroll
                    for (int n = 0; n < 2; ++n) acc[a][b][m][n] = (f32x4){0.f, 0.f, 0.f, 0.f};
        cur = nxt; cA = nA; cB = nB; ++ui;
        if constexpr (ALIGN_EPI) { if (wr == 1) PG8_BAR; }
    }
    PG8_WAIT_V(0);
    if constexpr (!ALIGN_EPI) { if (wr == 0) PG8_BAR; }
    PG8_BAR;
    if constexpr (Epi::AFTER_DRAIN) { E.fused(acc, cur, wr, wc, fr, fq, lds, wid, lane); S.done(cur); }
#undef PG8_SA
#undef PG8_SB
#undef PG8_STAGE
#undef PG8_LDA
#undef PG8_LDB
#undef PG8_MMA
#undef PG8_WAIT_V
#undef PG8_WAIT_L
#undef PG8_BAR
#undef PG8_SCHED
}
}

namespace att {
#define LAS __attribute__((address_space(3)))
typedef short bf16x8 __attribute__((ext_vector_type(8)));
typedef short s16x4 __attribute__((ext_vector_type(4)));
typedef float f32x16 __attribute__((ext_vector_type(16)));
typedef float f32x4 __attribute__((ext_vector_type(4)));
typedef unsigned u32x4 __attribute__((ext_vector_type(4)));
typedef unsigned u32x2 __attribute__((ext_vector_type(2)));
typedef LAS unsigned char lchar;
typedef unsigned short bf16_t;
constexpr int MP = 32768, LDQ = 3072;
constexpr float LOG2E = 1.4426950408889634f;
constexpr float C2 = 0.125f * LOG2E;
constexpr float NEG_BIG = -1e30f;

struct Params {
    const bf16_t* qkv;
    const float *cdk, *cdv, *csk, *csv;
    bf16_t* mixed;
    unsigned* queue;
    float lam;
};

__device__ __forceinline__ int crow(int r, int hi) { return (r & 3) + 8 * (r >> 2) + 4 * hi; }
typedef float f32x2_t __attribute__((ext_vector_type(2))); typedef __bf16 bf16x2_t __attribute__((ext_vector_type(2)));
__device__ __forceinline__ unsigned cvtpk(float lo, float hi) { const f32x2_t v = {lo, hi}; const bf16x2_t b = __builtin_convertvector(v, bf16x2_t); return __builtin_bit_cast(unsigned, b); }
__device__ __forceinline__ u32x4 pack8(f32x4 a, f32x4 b) { u32x4 w; w.x = cvtpk(a[0], a[1]); w.y = cvtpk(a[2], a[3]); w.z = cvtpk(b[0], b[1]); w.w = cvtpk(b[2], b[3]); return w; }
__device__ __forceinline__ bf16x8 vfrag(const lchar* p0, const lchar* p1) {
    const s16x4 a = __builtin_bit_cast(s16x4, __builtin_amdgcn_ds_read_tr16_b64_v4i16((LAS s16x4*)p0));
    const s16x4 b = __builtin_bit_cast(s16x4, __builtin_amdgcn_ds_read_tr16_b64_v4i16((LAS s16x4*)p1));
    return (bf16x8){a[0], a[1], a[2], a[3], b[0], b[1], b[2], b[3]};
}
__device__ __forceinline__ bf16x8 pfrag(const f32x16& p, int s) {
    u32x4 w; w.x = cvtpk(p[8 * s + 0], p[8 * s + 1]); w.y = cvtpk(p[8 * s + 2], p[8 * s + 3]); w.z = cvtpk(p[8 * s + 4], p[8 * s + 5]); w.w = cvtpk(p[8 * s + 6], p[8 * s + 7]);
    return __builtin_bit_cast(bf16x8, w);
}
__device__ __forceinline__ int offKd(int row, int ch) { return row * 256 + ((ch ^ (row & 15)) << 4); }
__device__ __forceinline__ int offVd(int row, int ch) { return row * 256 + ((ch ^ (((row & 3) << 2) | ((row >> 2) & 3))) << 4); }
__device__ __forceinline__ int offKs(int row, int ch) { return row * 128 + ((ch ^ (row & 7)) << 4); }
__device__ __forceinline__ int offVs(int row, int ch) { return row * 128 + ((ch ^ (((row >> 1) & 1) << 2)) << 4); }

constexpr int DBUF = 32768;
constexpr int SBUF = 16384;

__device__ __forceinline__ void diff_sub(const lchar* Kb, const lchar* Vb, int sub, int map, const bf16x8 (&qf)[4], f32x16 (&O)[4],
                                         float& m0, float& l0, float dq, float sl2, int lane) {
    const int r32 = lane & 31, hi = lane >> 5;
    f32x16 s;
#pragma unroll
    for (int r = 0; r < 16; ++r) s[r] = -sl2 * __builtin_fabsf(dq - (float)((r & 3) + 8 * (r >> 2)));
    const int krow = sub * 32 + r32;
    bf16x8 kf[4];
#pragma unroll
    for (int ds = 0; ds < 4; ++ds) kf[ds] = *(const LAS bf16x8*)(Kb + offKd(krow, 8 * map + 2 * ds + hi));
    const int q4 = (lane & 15) >> 2, p = lane & 3, g1 = (lane >> 4) & 1;
    bf16x8 vf[2][4];
#pragma unroll
    for (int sk = 0; sk < 2; ++sk)
#pragma unroll
        for (int d = 0; d < 4; ++d) {
            const int ch = d * 4 + 2 * g1 + (p >> 1);
            const int ra = sub * 32 + 16 * sk + 4 * hi + q4, rb = ra + 8;
            vf[sk][d] = vfrag(Vb + offVd(ra, ch) + 8 * (p & 1), Vb + offVd(rb, ch) + 8 * (p & 1));
        }
#pragma unroll
    for (int ds = 0; ds < 4; ++ds) s = __builtin_amdgcn_mfma_f32_32x32x16_bf16(kf[ds], qf[ds], s, 0, 0, 0);
    float mx = s[0];
#pragma unroll
    for (int r = 1; r < 16; ++r) mx = __builtin_fmaxf(mx, s[r]);
    mx = __builtin_fmaxf(mx, __shfl_xor(mx, 32));
    const float n0 = __builtin_fmaxf(m0, mx);
    if (__any(n0 > m0 + 8.f)) {
        const float f0 = __builtin_amdgcn_exp2f(__builtin_fmaxf(m0 - n0, -200.f));
        l0 *= f0;
#pragma unroll
        for (int d = 0; d < 4; ++d)
#pragma unroll
            for (int r = 0; r < 16; ++r) O[d][r] *= f0;
        m0 = n0;
    }
    float a0 = 0.f;
#pragma unroll
    for (int r = 0; r < 16; ++r) { s[r] = __builtin_amdgcn_exp2f(__builtin_fmaxf(s[r] - m0, -200.f)); a0 += s[r]; }
    l0 += a0;
    bf16x8 p0[2];
    p0[0] = pfrag(s, 0); p0[1] = pfrag(s, 1);
#pragma unroll
    for (int sk = 0; sk < 2; ++sk)
#pragma unroll
        for (int d = 0; d < 4; ++d) O[d] = __builtin_amdgcn_mfma_f32_32x32x16_bf16(vf[sk][d], p0[sk], O[d], 0, 0, 0);
}

__device__ __forceinline__ u32x4 ld_f32x8_bf16(const float* p) { const f32x4 a = *(const f32x4*)p, b = *(const f32x4*)(p + 4); return pack8(a, b); }

template <bool SAMPLE>
__device__ __forceinline__ void diff_unit(lchar* lds, const Params& P, const LAS float* gt, int b, int h, int qb) {
    int tid_ = threadIdx.x; asm volatile("" : "+v"(tid_));
    const int tid = tid_, lane = tid & 63, wid = __builtin_amdgcn_readfirstlane(tid >> 6), r32 = lane & 31, hi = lane >> 5;
    const int map = wid & 1, qg = SAMPLE ? ((wid >> 1) & 1) : (wid >> 1);
    const int q0 = SAMPLE ? 0 : qb * 128;
    const size_t qrow_g = SAMPLE ? (size_t)MP + b * 64 + qg * 32 + r32 : (size_t)b * 2048 + q0 + qg * 32 + r32;
    const int qpos = SAMPLE ? 4096 + qg * 32 + r32 : q0 + qg * 32 + r32;
    const int ntiles = SAMPLE ? 65 : 2 * qb + 2;
    const int tw = SAMPLE ? 64 : (q0 + qg * 32) >> 6;
    const bool compute_wave = true;
    const bool epi_wave = SAMPLE ? (wid < 4) : true;
    const int ksub = wid >> 2;
    const float sl2 = __builtin_amdgcn_exp2f(-2.0f * (float)(h + 1)) * LOG2E;
    bf16x8 qf[4];
#pragma unroll
    for (int ds = 0; ds < 4; ++ds) qf[ds] = *(const bf16x8*)(P.qkv + qrow_g * LDQ + h * 128 + map * 64 + ds * 16 + hi * 8);
    f32x16 O[4];
#pragma unroll
    for (int d = 0; d < 4; ++d) O[d] = (f32x16){};
    float m0 = NEG_BIG, l0 = 0.f;

    auto kvbf = [&](int which, int t, int row, int ch) -> const bf16_t* {
        const size_t r = SAMPLE ? (size_t)MP + b * 64 + row : (size_t)b * 2048 + t * 64 + row;
        return P.qkv + r * LDQ + (which ? 1024 : 512) + h * 128 + ch * 8; };
    auto kvf32 = [&](int which, int t, int row, int ch) -> const float* { return (which ? P.cdv : P.cdk) + ((size_t)b * 4096 + t * 64 + row) * 512 + h * 128 + ch * 8; };
    {
        u32x4 rk[2], rv[2]; f32x4 fk[SAMPLE ? 4 : 1], fv[SAMPLE ? 4 : 1];
        auto tile_load = [&](int t) {
#pragma unroll
            for (int i = 0; i < 2; ++i) { const int idx = tid + 512 * i, row = idx >> 4, ch = idx & 15;
                if (SAMPLE && t < 64) { const float* pk = kvf32(0, t, row, ch); const float* pv = kvf32(1, t, row, ch);
                    fk[(2 * i) % (SAMPLE ? 4 : 1)] = *(const f32x4*)pk; fk[(2 * i + 1) % (SAMPLE ? 4 : 1)] = *(const f32x4*)(pk + 4); fv[(2 * i) % (SAMPLE ? 4 : 1)] = *(const f32x4*)pv; fv[(2 * i + 1) % (SAMPLE ? 4 : 1)] = *(const f32x4*)(pv + 4); }
                else { rk[i] = *(const u32x4*)kvbf(0, t, row, ch); rv[i] = *(const u32x4*)kvbf(1, t, row, ch); } } };
        auto tile_store = [&](int t, lchar* buf) {
#pragma unroll
            for (int i = 0; i < 2; ++i) { const int idx = tid + 512 * i, row = idx >> 4, ch = idx & 15;
                if (SAMPLE && t < 64) { rk[i] = pack8(fk[(2 * i) % (SAMPLE ? 4 : 1)], fk[(2 * i + 1) % (SAMPLE ? 4 : 1)]); rv[i] = pack8(fv[(2 * i) % (SAMPLE ? 4 : 1)], fv[(2 * i + 1) % (SAMPLE ? 4 : 1)]); }
                *(LAS u32x4*)(buf + offKd(row, ch)) = rk[i]; *(LAS u32x4*)(buf + 16384 + offVd(row, ch)) = rv[i]; } };
        tile_load(0); tile_store(0, lds);
        __syncthreads();
        for (int t = 0; t < ntiles; ++t) {
            const lchar* cur = lds + (t & 1) * DBUF; lchar* nxt = lds + ((t + 1) & 1) * DBUF;
            const bool more = (t + 1 < ntiles);
            if (more) tile_load(t + 1);
            if (SAMPLE) diff_sub(cur, cur + 16384, ksub, map, qf, O, m0, l0, (float)(qpos - t * 64 - ksub * 32 - 4 * hi), sl2, lane);
            else if (t <= tw) {
#pragma unroll
                for (int sub = 0; sub < 2; ++sub) diff_sub(cur, cur + 16384, sub, map, qf, O, m0, l0, (float)(qpos - t * 64 - sub * 32 - 4 * hi), sl2, lane);
            }
            if (more) tile_store(t + 1, nxt);
            __syncthreads();
        }
    }
    if (SAMPLE) {
        LAS float* cb2 = (LAS float*)lds + (wid & 3) * 4224 + lane;
        if (wid >= 4) { cb2[0] = m0; cb2[64] = l0;
#pragma unroll
            for (int d = 0; d < 4; ++d)
#pragma unroll
                for (int r = 0; r < 16; ++r) cb2[(2 + d * 16 + r) * 64] = O[d][r]; }
        __syncthreads();
        if (wid < 4) { const float mP = cb2[0], lP = cb2[64], mm = __builtin_fmaxf(m0, mP);
            const float f = __builtin_amdgcn_exp2f(__builtin_fmaxf(m0 - mm, -200.f)), fP = __builtin_amdgcn_exp2f(__builtin_fmaxf(mP - mm, -200.f));
            l0 = l0 * f + lP * fP; m0 = mm;
#pragma unroll
            for (int d = 0; d < 4; ++d)
#pragma unroll
                for (int r = 0; r < 16; ++r) O[d][r] = O[d][r] * f + cb2[(2 + d * 16 + r) * 64] * fP; }
        __syncthreads();
    }
    l0 += __shfl_xor(l0, 32);
    LAS float* xb = (LAS float*)lds + qg * 4096 + lane;
    if (epi_wave && map == 1) {
        const float i1 = P.lam / l0;
#pragma unroll
        for (int d = 0; d < 4; ++d)
#pragma unroll
            for (int r = 0; r < 16; ++r) xb[(d * 16 + r) * 64] = O[d][r] * i1;
    }
    __syncthreads();
    if (epi_wave && map == 0) {
        const float i0 = 1.0f / l0;
        float ss = 0.f;
#pragma unroll
        for (int d = 0; d < 4; ++d)
#pragma unroll
            for (int r = 0; r < 16; ++r) { const float o = O[d][r] * i0 - xb[(d * 16 + r) * 64]; O[d][r] = o; ss += o * o; }
        ss += __shfl_xor(ss, 32);
        const float rs = __builtin_amdgcn_rsqf(ss * (1.0f / 128.0f) + 1e-6f) * 0.8f;
        bf16_t* orow = P.mixed + qrow_g * 1024 + h * 128;
#pragma unroll
        for (int d = 0; d < 4; ++d)
#pragma unroll
            for (int G = 0; G < 4; ++G) {
                const int d0 = d * 32 + 8 * G + 4 * hi;
                u32x2 w; w.x = cvtpk(O[d][4 * G + 0] * rs * gt[d0 + 0], O[d][4 * G + 1] * rs * gt[d0 + 1]); w.y = cvtpk(O[d][4 * G + 2] * rs * gt[d0 + 2], O[d][4 * G + 3] * rs * gt[d0 + 3]);
                *(u32x2*)(orow + d0) = w;
            }
    }
}

__device__ __forceinline__ void sb_sub(const lchar* Kb, const lchar* Vb, int sub, bool diag, const bf16x8 (&qf)[4], f32x16 (&O)[2], float& R, int lane) {
    const int r32 = lane & 31, hi = lane >> 5;
    f32x16 z = {};
    const int krow = sub * 32 + r32;
    bf16x8 kf[4];
#pragma unroll
    for (int ds = 0; ds < 4; ++ds) kf[ds] = *(const LAS bf16x8*)(Kb + offKs(krow, 2 * ds + hi));
    const int q4 = (lane & 15) >> 2, p = lane & 3, g1 = (lane >> 4) & 1;
    bf16x8 vf[2][2];
#pragma unroll
    for (int s = 0; s < 2; ++s)
#pragma unroll
        for (int d = 0; d < 2; ++d) {
            const int ch = d * 4 + 2 * g1 + (p >> 1);
            const int ra = sub * 32 + 16 * s + 4 * hi + q4, rb = ra + 8;
            vf[s][d] = vfrag(Vb + offVs(ra, ch) + 8 * (p & 1), Vb + offVs(rb, ch) + 8 * (p & 1));
        }
#pragma unroll
    for (int ds = 0; ds < 4; ++ds) z = __builtin_amdgcn_mfma_f32_32x32x16_bf16(kf[ds], qf[ds], z, 0, 0, 0);
    f32x16 lk;
#pragma unroll
    for (int r = 0; r < 16; ++r) {
        const float zc = __builtin_amdgcn_fmed3f(z[r], -200.f, 80.f);
        float l = -__builtin_amdgcn_logf(1.0f + __builtin_amdgcn_exp2f(zc));
        float ls = zc + l;
        if (diag && !(crow(r, hi) < r32)) { l = 0.f; ls = NEG_BIG; }
        lk[r] = l; z[r] = ls;
    }
    float run = R;
#pragma unroll
    for (int G = 3; G >= 0; --G) {
        const float T = (lk[4 * G] + lk[4 * G + 1]) + (lk[4 * G + 2] + lk[4 * G + 3]);
        const float To = __shfl_xor(T, 32);
        const float a3 = run + (hi == 0 ? To : 0.f);
        const float a2 = a3 + lk[4 * G + 3], a1 = a2 + lk[4 * G + 2], a0 = a1 + lk[4 * G + 1];
        z[4 * G + 3] = __builtin_amdgcn_exp2f(__builtin_fmaxf(z[4 * G + 3] + a3, -200.f)); z[4 * G + 2] = __builtin_amdgcn_exp2f(__builtin_fmaxf(z[4 * G + 2] + a2, -200.f));
        z[4 * G + 1] = __builtin_amdgcn_exp2f(__builtin_fmaxf(z[4 * G + 1] + a1, -200.f)); z[4 * G + 0] = __builtin_amdgcn_exp2f(__builtin_fmaxf(z[4 * G + 0] + a0, -200.f));
        run += T + To;
    }
    R = run;
    bf16x8 pf[2]; pf[0] = pfrag(z, 0); pf[1] = pfrag(z, 1);
#pragma unroll
    for (int s = 0; s < 2; ++s)
#pragma unroll
        for (int d = 0; d < 2; ++d) O[d] = __builtin_amdgcn_mfma_f32_32x32x16_bf16(vf[s][d], pf[s], O[d], 0, 0, 0);
}

__device__ __forceinline__ void sb_unit(const bool SAMPLE, lchar* lds, const Params& P, int b, int h, int qb) {
    int tid_ = threadIdx.x; asm volatile("" : "+v"(tid_));
    const int tid = tid_, lane = tid & 63, wid = __builtin_amdgcn_readfirstlane(tid >> 6), r32 = lane & 31, hi = lane >> 5;
    const int q0 = SAMPLE ? 4096 : qb * 256;
    const int wq0 = q0 + (SAMPLE ? (wid & 1) : wid) * 32;
    const size_t qrow_g = SAMPLE ? (size_t)MP + b * 64 + (wid & 1) * 32 + r32 : (size_t)b * 2048 + wq0 + r32;
    const int thi = SAMPLE ? 64 : 4 * qb + 3;
    const int tw = wq0 >> 6, sw = (wq0 >> 5) & 1;
    const bool compute_wave = SAMPLE ? (wid < 2) : true;
    bf16x8 qf[4];
#pragma unroll
    for (int ds = 0; ds < 4; ++ds) qf[ds] = *(const bf16x8*)(P.qkv + qrow_g * LDQ + 1536 + h * 64 + ds * 16 + hi * 8);
    f32x16 O[2]; O[0] = (f32x16){}; O[1] = (f32x16){};
    float R = 0.f;
    auto compute = [&](int t, const lchar* cur) {
        if (t > tw) return;
        if (__all(R < -160.f)) return;
        if (t == tw) {
            if (sw == 1) { sb_sub(cur, cur + 8192, 1, true, qf, O, R, lane); sb_sub(cur, cur + 8192, 0, false, qf, O, R, lane); }
            else sb_sub(cur, cur + 8192, 0, true, qf, O, R, lane);
        } else { sb_sub(cur, cur + 8192, 1, false, qf, O, R, lane); sb_sub(cur, cur + 8192, 0, false, qf, O, R, lane); }
    };
    auto kvload = [&](int which, int t, int row, int ch) -> u32x4 {
        if (SAMPLE && t < 64) return ld_f32x8_bf16((which ? P.csv : P.csk) + ((size_t)b * 4096 + t * 64 + row) * 512 + h * 64 + ch * 8);
        const size_t r = SAMPLE ? (size_t)MP + b * 64 + row : (size_t)b * 2048 + t * 64 + row;
        return *(const u32x4*)(P.qkv + r * LDQ + (which ? 2560 : 2048) + h * 64 + ch * 8); };
    {
        const int row = tid >> 3, ch = tid & 7;
        u32x4 rk = kvload(0, thi, row, ch), rv = kvload(1, thi, row, ch);
        *(LAS u32x4*)(lds + offKs(row, ch)) = rk; *(LAS u32x4*)(lds + 8192 + offVs(row, ch)) = rv;
        __syncthreads();
        int par = 0;
        volatile LAS int* dflag = (volatile LAS int*)(lds + 131072 + 1600);
        for (int t = thi; t >= 0; --t, par ^= 1) {
            const lchar* cur = lds + par * SBUF; lchar* nxt = lds + (par ^ 1) * SBUF;
            if (t > 0) { rk = kvload(0, t - 1, row, ch); rv = kvload(1, t - 1, row, ch); }
            if (compute_wave) compute(t, cur);
            if (t > 0) { *(LAS u32x4*)(nxt + offKs(row, ch)) = rk; *(LAS u32x4*)(nxt + 8192 + offVs(row, ch)) = rv; }
            const int wdone = (!compute_wave || (t <= tw && __all(R < -160.f))) ? 1 : 0;
            if (lane == 0) dflag[par * 8 + wid] = wdone;
            __syncthreads();
            int alld = 1;
#pragma unroll
            for (int w = 0; w < 8; ++w) alld &= dflag[par * 8 + w];
            if (alld) break;
        }
    }
    if (compute_wave) {
        bf16_t* orow = P.mixed + qrow_g * 1024 + 512 + h * 64;
#pragma unroll
        for (int d = 0; d < 2; ++d)
#pragma unroll
            for (int G = 0; G < 4; ++G) {
                const int d0 = d * 32 + 8 * G + 4 * hi;
                u32x2 w; w.x = cvtpk(O[d][4 * G + 0], O[d][4 * G + 1]); w.y = cvtpk(O[d][4 * G + 2], O[d][4 * G + 3]);
                *(u32x2*)(orow + d0) = w;
            }
    }
}

constexpr int N_UNITS = 192 + 8 * 256;
__device__ __forceinline__ void attn_phase(lchar* lds, Params P, const float* subln_g, int u_base, int u_end) {
    LAS float* gt = (LAS float*)(lds + 131072 + 1024);
    volatile LAS int* slot = (volatile LAS int*)(lds + 131072 + 1536);
    if (threadIdx.x < 128) gt[threadIdx.x] = subln_g[threadIdx.x];
    __syncthreads();
    for (;;) {
        if (threadIdx.x == 0) *slot = u_base + (int)atomicAdd(P.queue, 1u);
        __syncthreads();
        const int u = __builtin_amdgcn_readfirstlane(*slot);
        __syncthreads();
        if (u >= u_end) break;
        if (u < 64) { diff_unit<true>(lds, P, gt, u >> 2, u & 3, 0); }
        else if (u < 192) { const int j = u - 64; sb_unit(true, lds, P, j >> 3, j & 7, 0); }
        else {
            const int j = u - 192, g = 7 - (j >> 8), k = j & 255;
            if (k < 128) { diff_unit<false>(lds, P, gt, (k & 63) >> 2, k & 3, 2 * g + 1 - (k >> 6)); }
            else { const int kk = k - 128; sb_unit(false, lds, P, kk >> 3, kk & 7, g); }
        }
    }
}
#undef LAS
}

#define GAS __attribute__((address_space(1)))
#define LAS __attribute__((address_space(3)))
typedef unsigned short bf16;
typedef unsigned v4u __attribute__((ext_vector_type(4)));
typedef float f32x4 __attribute__((ext_vector_type(4)));
constexpr int NWAVES = 8;
constexpr int MT = 33792, MP = 32768, DM = 1024, NIN = 3072, FF = 2816;
constexpr size_t MiB = 1u << 20;
constexpr size_t WS_CTL = 0;
constexpr size_t WS_WIN = 1 * MiB;
constexpr size_t WS_WOUT = 7 * MiB;
constexpr size_t WS_WGU = 9 * MiB;
constexpr size_t WS_WDN = 20 * MiB;
constexpr size_t WS_SSQ1 = 26 * MiB;
constexpr size_t WS_SSQ2 = 29 * MiB;
constexpr size_t WS_XN = 32 * MiB;
constexpr size_t WS_HB = 100 * MiB;
constexpr size_t WS_QKV = 168 * MiB;
constexpr size_t WS_CACHE = 368 * MiB;
constexpr size_t WS_END = 624 * MiB;
constexpr int RING_BYTES = 131072, LDS_BYTES = 147456;

__device__ __forceinline__ unsigned f2bf(float f) { unsigned u = __builtin_bit_cast(unsigned, f); return (u + 0x7fffu + ((u >> 16) & 1u)) >> 16; }
__device__ __forceinline__ unsigned pk2(float lo, float hi) { return f2bf(lo) | (f2bf(hi) << 16); }
__device__ __forceinline__ float wave_sum(float v) {
#pragma unroll
    for (int o = 1; o < 64; o <<= 1) v += __shfl_xor(v, o);
    return v;
}
__device__ __forceinline__ void transpose_item(const float* W, int K, int N, bf16* WT, int k0, int n0, int orow0, const float* kscale, LAS float* scr, int lane) {
#pragma unroll 8
    for (int i = 0; i < 32; ++i) { const int kk = 2 * i + (lane >> 5); float v = W[(size_t)(k0 + kk) * N + n0 + (lane & 31)]; if (kscale) v *= kscale[k0 + kk]; scr[kk * 33 + (lane & 31)] = v; }
    asm volatile("s_waitcnt lgkmcnt(0)" ::: "memory");
    const int c = lane & 7;
#pragma unroll
    for (int j = 0; j < 4; ++j) { const int n = (lane >> 3) + 8 * j; const LAS float* s = scr + (8 * c) * 33 + n;
        v4u o; o.x = pk2(s[0 * 33], s[1 * 33]); o.y = pk2(s[2 * 33], s[3 * 33]); o.z = pk2(s[4 * 33], s[5 * 33]); o.w = pk2(s[6 * 33], s[7 * 33]);
        *(v4u*)(WT + (size_t)(orow0 + n) * K + k0 + 8 * c) = o; }
    asm volatile("s_waitcnt lgkmcnt(0)" ::: "memory");
}

#define XB_TMO      128
#define XB_XCNT(j)  (256  + 64 * (j))
#define XB_XSUB(j)  (1280 + 64 * (j))
#define XB_XGEN(j)  (2304 + 64 * (j))
#define XB_TOP      3328
#define XB_TOPGEN   3392
#define XCD_BAR_WORDS 3456
#define XB_SPIN_CAP (1u << 18)

__device__ __forceinline__ unsigned xb_ld(unsigned* p)              { return __hip_atomic_load(p, __ATOMIC_RELAXED, __HIP_MEMORY_SCOPE_AGENT); }
__device__ __forceinline__ unsigned xb_add(unsigned* p, unsigned v) { return __hip_atomic_fetch_add(p, v, __ATOMIC_RELAXED, __HIP_MEMORY_SCOPE_AGENT); }
__device__ __forceinline__ unsigned xb_xcc_id() { return (unsigned)__builtin_amdgcn_s_getreg((3 << 11) | 20) & 0xFu; }
#define XB_SPIN(cond, bar) do { unsigned _sp = 0; while (cond) { __builtin_amdgcn_s_sleep(1); \
    if ((++_sp & 255u) == 0u) { if (xb_ld(&(bar)[XB_TMO])) break; if (_sp > XB_SPIN_CAP) { atomicAdd(&(bar)[XB_TMO], 1u); break; } } } } while (0)

struct XcdBarrier {
    unsigned* bar; unsigned x;
    volatile LAS unsigned* st;
};

__device__ __forceinline__ XcdBarrier xcd_barrier_post(unsigned* bar, volatile LAS unsigned* st) {
    XcdBarrier b; b.bar = bar; b.x = xb_xcc_id(); b.st = st;
    if (threadIdx.x == 0) (void)xb_add(&bar[XB_XCNT(b.x)], 1u);
    return b;
}
__device__ __forceinline__ void xcd_barrier_complete(unsigned* bar, unsigned x, unsigned& nloc, unsigned& nx) {
    const unsigned G = gridDim.x * gridDim.y * gridDim.z;
    unsigned sum, cnt, mine, sp = 0u;
    for (;;) {
        sum = 0u; cnt = 0u; mine = 0u;
#pragma unroll
        for (unsigned j = 0; j < 16; ++j) { const unsigned c = xb_ld(&bar[XB_XCNT(j)]); sum += c; cnt += (c > 0u) ? 1u : 0u; mine = (j == x) ? c : mine; }
        if (sum == G) break;
        __builtin_amdgcn_s_sleep(1);
        if ((++sp & 255u) == 0u) { if (xb_ld(&bar[XB_TMO])) break; if (sp > XB_SPIN_CAP) { atomicAdd(&bar[XB_TMO], 1u); break; } }
    }
    nloc = mine > 0u ? mine : 1u; nx = cnt > 0u ? cnt : 1u;
}

__device__ __forceinline__ void xcd_barrier(const XcdBarrier& b) {
    asm volatile("s_waitcnt vmcnt(0)" ::: "memory");
    __syncthreads();
    if (threadIdx.x == 0) {
        unsigned* bar = b.bar;
        __builtin_amdgcn_s_waitcnt(0);
        unsigned nloc = b.st[0], nx = b.st[1];
        if (nloc == 0u) { xcd_barrier_complete(bar, b.x, nloc, nx); b.st[0] = nloc; b.st[1] = nx; }
        const unsigned old = xb_add(&bar[XB_XSUB(b.x)], 1u);
        const unsigned gen = old / nloc;
        if (old + 1u == (gen + 1u) * nloc) {
            __builtin_amdgcn_fence(__ATOMIC_RELEASE, "agent");
            asm volatile("s_waitcnt vmcnt(0)" ::: "memory");
            const unsigned og = xb_add(&bar[XB_TOP], 1u);
            const unsigned tg = og / nx;
            if (og + 1u == (tg + 1u) * nx) xb_add(&bar[XB_TOPGEN], 1u);
            else XB_SPIN(xb_ld(&bar[XB_TOPGEN]) == tg, bar);
            __builtin_amdgcn_fence(__ATOMIC_ACQUIRE, "agent");
            xb_add(&bar[XB_XGEN(b.x)], 1u);
            asm volatile("s_waitcnt vmcnt(0)" ::: "memory");
        } else {
            XB_SPIN(xb_ld(&bar[XB_XGEN(b.x)]) == gen, bar);
            __builtin_amdgcn_fence(__ATOMIC_ACQUIRE, "agent");
            asm volatile("s_waitcnt vmcnt(0)" ::: "memory");
        }
    }
    __syncthreads();
}


struct Args {
    const float* in[19]; float* out; unsigned char* ws; int ph_lo, ph_hi; int isz[20];
};

__global__ void __launch_bounds__(NWAVES * 64, 2) fwd_kernel(Args args) {
    extern __shared__ __attribute__((aligned(16))) unsigned char lds_raw[];
    LAS unsigned char* lds = (LAS unsigned char*)lds_raw;
    const int tid = threadIdx.x, lane = tid & 63, wave = __builtin_amdgcn_readfirstlane(tid >> 6);
    const int G = gridDim.x;
    unsigned char* ws = args.ws;
    const float* xp = args.in[0]; const float* xs = args.in[1];
    float* out = args.out;
    bf16* Win_t = (bf16*)(ws + WS_WIN); bf16* Wout_t = (bf16*)(ws + WS_WOUT); bf16* Wgu_t = (bf16*)(ws + WS_WGU); bf16* Wdn_t = (bf16*)(ws + WS_WDN);
    bf16* XN = (bf16*)(ws + WS_XN); bf16* HB = (bf16*)(ws + WS_HB); bf16* QKV = (bf16*)(ws + WS_QKV); bf16* ACT = (bf16*)(ws + WS_QKV);
    float* SSQ1 = (float*)(ws + WS_SSQ1); float* SSQ2 = (float*)(ws + WS_SSQ2);
    const int lo = args.ph_lo, hi = args.ph_hi;
#define IN(k) (lo <= (k) && (k) < hi)
    unsigned* barw = (unsigned*)(ws + WS_CTL) + 1024;
    volatile LAS unsigned* MISC = (volatile LAS unsigned*)(lds + 131072 + 320);
    if (tid == 0) { MISC[8] = 0u; MISC[9] = 0u; }
    __syncthreads();
    XcdBarrier xbar = xcd_barrier_post(barw, MISC + 8);
    if (args.ph_lo == 0x7fffffff) cg::this_grid().sync();
#define SEAM(k) do { if (IN(k) && IN((k) + 1)) { xcd_barrier(xbar); } } while (0)

    if (IN(0)) {
        if (blockIdx.x == 0 && tid == 0) { __hip_atomic_store((unsigned*)(ws + WS_CTL), 0u, __ATOMIC_RELAXED, __HIP_MEMORY_SCOPE_AGENT); __hip_atomic_store((unsigned*)(ws + WS_CTL) + 64, 0u, __ATOMIC_RELAXED, __HIP_MEMORY_SCOPE_AGENT); }
        LAS float* scr = (LAS float*)(lds + wave * 16384);
        const int gw = blockIdx.x * NWAVES + wave, NGW = G * NWAVES;
        constexpr int I_IN = 16 * 96, I_OUT = 16 * 32, I_G = 16 * 88, I_D = 44 * 32;
        constexpr int NITEMS = I_IN + I_OUT + 2 * I_G + I_D;
        const float* w_in = args.in[7]; const float* w_out = args.in[13]; const float* g_ffn = args.in[14];
        const float* w_gate = args.in[15]; const float* w_up = args.in[16]; const float* w_down = args.in[17];
        for (int it = gw; it < NITEMS; it += NGW) {
            int r = it;
            if (r < I_IN) { const int kb = r / 96, nb = r % 96; transpose_item(w_in, DM, NIN, Win_t, 64 * kb, 32 * nb, 32 * nb, nullptr, scr, lane); continue; } r -= I_IN;
            if (r < I_OUT) { const int kb = r / 32, nb = r % 32; transpose_item(w_out, DM, DM, Wout_t, 64 * kb, 32 * nb, 32 * nb, nullptr, scr, lane); continue; } r -= I_OUT;
            if (r < I_G) { const int kb = r / 88, nb = r % 88, n0 = 32 * nb; transpose_item(w_gate, DM, FF, Wgu_t, 64 * kb, n0, 256 * (n0 >> 7) + (n0 & 127), g_ffn, scr, lane); continue; } r -= I_G;
            if (r < I_G) { const int kb = r / 88, nb = r % 88, n0 = 32 * nb; transpose_item(w_up, DM, FF, Wgu_t, 64 * kb, n0, 256 * (n0 >> 7) + 128 + (n0 & 127), g_ffn, scr, lane); continue; } r -= I_G;
            { const int kb = r / 32, nb = r % 32; transpose_item(w_down, FF, DM, Wdn_t, 64 * kb, 32 * nb, 32 * nb, nullptr, scr, lane); }
        }
        const float* g_attn = args.in[6];
        f32x4 gv[4];
#pragma unroll
        for (int j = 0; j < 4; ++j) gv[j] = ((const f32x4*)g_attn)[lane + 64 * j];
        for (int m = gw; m < MT; m += NGW) {
            const float* xrow = (m < MP) ? xp + (size_t)m * DM : xs + (size_t)(m - MP) * DM;
            const f32x4* xr = (const f32x4*)xrow + lane;
            f32x4 v[4]; float s = 0.f;
#pragma unroll
            for (int j = 0; j < 4; ++j) { v[j] = xr[64 * j]; s += (v[j].x * v[j].x + v[j].y * v[j].y) + (v[j].z * v[j].z + v[j].w * v[j].w); }
            const float rstd = __builtin_amdgcn_rsqf(wave_sum(s) * (1.f / DM) + 1e-6f);
            unsigned long long* o8 = (unsigned long long*)(XN + (size_t)m * DM) + lane;
#pragma unroll
            for (int j = 0; j < 4; ++j) { const f32x4 w = v[j] * rstd * gv[j]; o8[64 * j] = (unsigned long long)pk2(w.x, w.y) | ((unsigned long long)pk2(w.z, w.w) << 32); }
        }
    }
    SEAM(0);

    if (IN(1)) {
        pg8::Gemm g{XN, Win_t, MT, NIN, DM}; pg8::StaticOrder S; S.init(MT, NIN, G, (int)blockIdx.x);
        pg8::EpiQKV E{QKV, out, att::C2};
        pg8::gemm_phase<pg8::EpiQKV, pg8::StaticOrder, true, true>(lds, g, S, E);
    }
    SEAM(1);

    if (IN(2)) {
        const float d1 = wave_sum(args.in[8][lane] * args.in[9][lane]), d2 = wave_sum(args.in[10][lane] * args.in[11][lane]);
        att::Params P;
        P.qkv = QKV; P.cdk = args.in[2]; P.cdv = args.in[3]; P.csk = args.in[4]; P.csv = args.in[5]; P.mixed = XN; P.queue = (unsigned*)(ws + WS_CTL);
        P.lam = __expf(d1) - __expf(d2) + 0.2f;
        att::attn_phase(lds, P, args.in[12], 0, att::N_UNITS);
    }
    SEAM(2);

    if (IN(3)) {
        pg8::Gemm g{XN, Wout_t, MT, DM, DM};
        pg8::StaticOrder S; S.init(MT, DM, G, (int)blockIdx.x);
        pg8::EpiRes E{xp, xs, out, HB, SSQ1};
        pg8::gemm_phase<pg8::EpiRes, pg8::StaticOrder, true, true>(lds, g, S, E);
    }
    SEAM(3);

    if (IN(4)) {
        pg8::Gemm g{HB, Wgu_t, MT, 2 * FF, DM}; pg8::StaticOrder S; S.init(MT, 2 * FF, G, (int)blockIdx.x);
        pg8::EpiSwiGLU E{ACT, SSQ1};
        pg8::gemm_phase<pg8::EpiSwiGLU, pg8::StaticOrder, true, true>(lds, g, S, E);
    }
    SEAM(4);

    if (IN(5)) {
        pg8::Gemm g{ACT, Wdn_t, MT, DM, FF}; pg8::StaticOrder S; S.init(MT, DM, G, (int)blockIdx.x);
        pg8::EpiRes E{out, out + (size_t)MP * DM, out, nullptr, SSQ2};
        pg8::gemm_phase<pg8::EpiRes, pg8::StaticOrder, true, true>(lds, g, S, E);
    }
    SEAM(5);

    if (IN(6)) {
        const int gw = blockIdx.x * NWAVES + wave, NGW = G * NWAVES;
        const float* g_fin = args.in[18];
        f32x4 gv[4];
#pragma unroll
        for (int j = 0; j < 4; ++j) gv[j] = ((const f32x4*)g_fin)[lane + 64 * j];
        for (int m = gw; m < MT; m += NGW) {
            const float pss = (lane < 16) ? SSQ2[((size_t)(lane >> 2) * MT + m) * 4 + (lane & 3)] : 0.f;
            const float rstd = __builtin_amdgcn_rsqf(wave_sum(pss) * (1.f / DM) + 1e-6f);
            f32x4* yr = (f32x4*)(out + (size_t)m * DM) + lane;
#pragma unroll
            for (int j = 0; j < 4; ++j) yr[64 * j] = yr[64 * j] * rstd * gv[j];
        }
    }
#undef IN
#undef SEAM
}

#ifndef MK_N_LAUNCHES
#define MK_N_LAUNCHES 1
#endif
extern "C" void kernel_launch(void* const* d_in, const int* in_sizes, int n_in, void* d_out, int out_size, void* d_ws, size_t ws_size, hipStream_t stream) {
    static int grid = 0;
    if (grid == 0) {
        if (n_in != 19 || ws_size < WS_END) { fprintf(stderr, "kernel_launch: unexpected n_in %d or ws_size %zu\n", n_in, ws_size); grid = -1; return; }
        int dev = 0, cus = 0, per_cu = 0;
        hipGetDevice(&dev); hipDeviceGetAttribute(&cus, hipDeviceAttributeMultiprocessorCount, dev);
        hipFuncSetAttribute((const void*)fwd_kernel, hipFuncAttributeMaxDynamicSharedMemorySize, LDS_BYTES);
        hipOccupancyMaxActiveBlocksPerMultiprocessor(&per_cu, (const void*)fwd_kernel, NWAVES * 64, LDS_BYTES);
        if (per_cu < 1) { fprintf(stderr, "kernel_launch: occupancy query says %d blocks per CU\n", per_cu); per_cu = 1; }
        (void)hipGetLastError();
        grid = cus * per_cu;
    }
    if (grid < 0) return;
    (void)hipMemsetAsync((char*)d_ws + WS_CTL, 0, 32768, stream);
    Args a{};
    for (int i = 0; i < 19; ++i) a.in[i] = (const float*)d_in[i];
    a.out = (float*)d_out; a.ws = (unsigned char*)d_ws; for (int i = 0; i < 19; ++i) a.isz[i] = in_sizes[i];
    if (MK_N_LAUNCHES == 1) {
        a.ph_lo = 0; a.ph_hi = 7;
        void* kargs[] = {&a};
        hipError_t e = hipLaunchCooperativeKernel((const void*)fwd_kernel, dim3(grid), dim3(NWAVES * 64), kargs, LDS_BYTES, stream);
        if (e != hipSuccess) fprintf(stderr, "cooperative launch failed: %s (grid %d)\n", hipGetErrorString(e), grid);
    } else {
        for (int ph = 0; ph < 7; ++ph) { a.ph_lo = ph; a.ph_hi = ph + 1; hipLaunchKernelGGL(fwd_kernel, dim3(grid), dim3(NWAVES * 64), LDS_BYTES, stream, a); }
    }
}
```

```cpp
#include <hip/hip_runtime.h>
#include <hip/hip_cooperative_groups.h>
#include <cstdio>
#include <cstdint>
namespace cg = cooperative_groups;
namespace pg8 {
#define PG8_LAS __attribute__((address_space(3)))
typedef unsigned short bf16_t;
typedef short bf16x8 __attribute__((ext_vector_type(8)));
typedef float f32x4 __attribute__((ext_vector_type(4)));
typedef unsigned u32x4 __attribute__((ext_vector_type(4)));
constexpr int BM = 256, BK = 64, HALF = 128, HTB = HALF * BK * 2  , STAGE_BYTES = 8 * HTB, NXCD = 8, WGM = 8;

__host__ __device__ __forceinline__ int lds_byte(int r, int c) { const int st = (r >> 4) * 2 + (c >> 5), rr = r & 15, cc = c & 31, ob = rr * 64 + cc * 2; return st * 1024 + (ob ^ (((ob >> 9) & 1) << 5)); }
__host__ __device__ __forceinline__ void stage_rc(int b, int& R, int& C) { const int st = b / 1024, sb = b % 1024, swz = sb ^ (((sb >> 9) & 1) << 5); R = (st >> 1) * 16 + swz / 64; C = (st & 1) * 32 + (swz % 64) / 2; }
__host__ __device__ __forceinline__ int perm32(int rho) { const int n = rho >> 4, i = rho & 15; return 8 * (i >> 2) + 4 * n + (i & 3); }

struct Unit { int pm, pn; };
struct Gemm { const bf16_t* A; const bf16_t* Bt; int M, N, K; };

struct StaticOrder {
    int nM, nN, nwg, G, c;
    __host__ __device__ void init(int M, int N, int G_, int c_) { nM = M / BM; nN = N / BM; nwg = nM * nN; G = G_; c = c_; }
    __host__ __device__ bool next(int i, Unit& u) const {
        const long L = (long)i * G + c; if (L >= nwg) return false;
        int wgid = (int)L; { const int q = nwg / NXCD, r = nwg % NXCD, xcd = wgid % NXCD, off = wgid / NXCD; wgid = (xcd < r ? xcd * (q + 1) : r * (q + 1) + (xcd - r) * q) + off; }
        const int nig = WGM * nN, gid = wgid / nig, fm = gid * WGM, gsz = (nM - fm) < WGM ? (nM - fm) : WGM;
        u.pm = fm + ((wgid % nig) % gsz); u.pn = (wgid % nig) / gsz; return true;
    }
    __device__ __forceinline__ void a_ready(const Unit&) const {}
    __device__ __forceinline__ void done(const Unit&) const {}
};

__device__ __forceinline__ unsigned cvt_pk_bf16(float lo, float hi) { unsigned r; asm volatile("v_cvt_pk_bf16_f32 %0, %1, %2" : "=v"(r) : "v"(lo), "v"(hi)); return r; }
typedef float f32x2 __attribute__((ext_vector_type(2)));

constexpr int MT = 33792;
constexpr int MP = 32768;
constexpr size_t OFF_PKV = (size_t)MT * 1024;
constexpr size_t OFF_SKV = OFF_PKV + 4ull * MP * 512;
constexpr float RMS_EPS = 1e-6f;
constexpr float LOG2E = 1.4426950408889634f;
typedef float f32x2 __attribute__((ext_vector_type(2)));

struct EpiQKV {
    static constexpr bool PERM = true, AFTER_DRAIN = false;
    bf16_t* qkv; float* out; float qscale;
    __device__ __forceinline__ void operator()(const f32x4 (&acc)[2][2][4][2], const Unit& u, int wr, int wc, int fr, int fq) const {
        const int seg = u.pn >> 1;
        const bool isq = (seg == 0) || (seg == 3);
        const float sc = isq ? qscale : 1.f;
        const int row0 = u.pm * BM + wr * 64 + fr, col0 = u.pn * BM + wc * 32 + 8 * fq;
        const int oi = (seg == 1) ? 0 : (seg == 2) ? 1 : (seg == 4) ? 2 : 3;
        const bool prompt = u.pm < (MP / BM);
        float* obase = prompt ? out + OFF_PKV + (size_t)oi * ((size_t)MP * 512) : out + OFF_SKV + (size_t)oi * (1024 * 512);
        const int orow0 = prompt ? row0 : row0 - MP;
        const int ocol0 = (u.pn & 1) * 256 + wc * 32 + 8 * fq;
#pragma unroll
        for (int ai = 0; ai < 2; ++ai)
#pragma unroll
            for (int m = 0; m < 4; ++m) {
                const int rr = ai * HALF + m * 16;
#pragma unroll
                for (int bj = 0; bj < 2; ++bj) {
                    const f32x4 v0 = acc[ai][bj][m][0], v1 = acc[ai][bj][m][1];
                    if (!isq) { float* op = obase + (size_t)(orow0 + rr) * 512 + ocol0 + bj * HALF; __builtin_nontemporal_store(v0, (f32x4*)op); __builtin_nontemporal_store(v1, (f32x4*)(op + 4)); }
                    u32x4 w; w.x = cvt_pk_bf16(v0[0] * sc, v0[1] * sc); w.y = cvt_pk_bf16(v0[2] * sc, v0[3] * sc); w.z = cvt_pk_bf16(v1[0] * sc, v1[1] * sc); w.w = cvt_pk_bf16(v1[2] * sc, v1[3] * sc);
                    *(u32x4*)(qkv + (size_t)(row0 + rr) * 3072 + col0 + bj * HALF) = w;
                }
            }
    }
};

struct EpiRes {
    static constexpr bool PERM = true, AFTER_DRAIN = false;
    const float* bp; const float* bs; float* Y; bf16_t* hb; float* ssq;
    __device__ __forceinline__ void operator()(const f32x4 (&acc)[2][2][4][2], const Unit& u, int wr, int wc, int fr, int fq) const {
        const int row0 = u.pm * BM + wr * 64 + fr, col0 = u.pn * BM + wc * 32 + 8 * fq;
        const bool prompt = u.pm < (MP / BM);
#pragma unroll
        for (int ai = 0; ai < 2; ++ai)
#pragma unroll
            for (int m = 0; m < 4; ++m) {
                const int row = row0 + ai * HALF + m * 16;
                const float* b = prompt ? bp + (size_t)row * 1024 : bs + (size_t)(row - MP) * 1024;
                float s = 0.f;
#pragma unroll
                for (int bj = 0; bj < 2; ++bj) {
                    const int col = col0 + bj * HALF;
                    const f32x4 v0 = acc[ai][bj][m][0] + *(const f32x4*)(b + col), v1 = acc[ai][bj][m][1] + *(const f32x4*)(b + col + 4);
                    float* yp = Y + (size_t)row * 1024 + col; *(f32x4*)yp = v0; *(f32x4*)(yp + 4) = v1;
                    if (hb) { u32x4 w; w.x = cvt_pk_bf16(v0[0], v0[1]); w.y = cvt_pk_bf16(v0[2], v0[3]); w.z = cvt_pk_bf16(v1[0], v1[1]); w.w = cvt_pk_bf16(v1[2], v1[3]);
                        *(u32x4*)(hb + (size_t)row * 1024 + col) = w; }
                    s += (v0[0] * v0[0] + v0[1] * v0[1]) + (v0[2] * v0[2] + v0[3] * v0[3]) + (v1[0] * v1[0] + v1[1] * v1[1]) + (v1[2] * v1[2] + v1[3] * v1[3]);
                }
                s += __shfl_xor(s, 16); s += __shfl_xor(s, 32);
                if (fq == 0) ssq[((size_t)u.pn * MT + row) * 4 + wc] = s;
            }
    }
};

struct EpiSwiGLU {
    static constexpr bool PERM = true, AFTER_DRAIN = false;
    bf16_t* act; const float* ssq;
    __device__ __forceinline__ void operator()(const f32x4 (&acc)[2][2][4][2], const Unit& u, int wr, int wc, int fr, int fq) const {
        const int row0 = u.pm * BM + wr * 64 + fr, col0 = u.pn * HALF + wc * 32 + 8 * fq;
#pragma unroll
        for (int ai = 0; ai < 2; ++ai)
#pragma unroll
            for (int m = 0; m < 4; ++m) {
                const int row = row0 + ai * HALF + m * 16;
                const f32x4 a = *(const f32x4*)(ssq + (size_t)row * 4), b = *(const f32x4*)(ssq + ((size_t)MT + row) * 4), c = *(const f32x4*)(ssq + ((size_t)2 * MT + row) * 4), d = *(const f32x4*)(ssq + ((size_t)3 * MT + row) * 4);
                const float tot = ((a[0] + a[1]) + (a[2] + a[3])) + ((b[0] + b[1]) + (b[2] + b[3])) + ((c[0] + c[1]) + (c[2] + c[3])) + ((d[0] + d[1]) + (d[2] + d[3]));
                const float rstd = __builtin_amdgcn_rsqf(tot * (1.0f / 1024.0f) + RMS_EPS);
                float o[8];
#pragma unroll
                for (int n = 0; n < 2; ++n)
#pragma unroll
                    for (int i = 0; i < 4; ++i) {
                        const float g = acc[ai][0][m][n][i] * rstd, up = acc[ai][1][m][n][i] * rstd;
                        o[n * 4 + i] = g * __builtin_amdgcn_rcpf(1.f + __builtin_amdgcn_exp2f(__builtin_fmaxf(-g * LOG2E, -126.f))) * up;
                    }
                u32x4 w; w.x = cvt_pk_bf16(o[0], o[1]); w.y = cvt_pk_bf16(o[2], o[3]); w.z = cvt_pk_bf16(o[4], o[5]); w.w = cvt_pk_bf16(o[6], o[7]);
                *(u32x4*)(act + (size_t)row * 2816 + col0) = w;
            }
    }
};
template <class Epi, class Sched, bool ALIGN_EPI = false, bool SP2 = false>
__device__ __forceinline__ void gemm_phase(PG8_LAS unsigned char* lds, const Gemm g, const Sched& S, const Epi& E) {
    const int tid = threadIdx.x, wid = __builtin_amdgcn_readfirstlane(tid >> 6), lane = tid & 63, wr = wid >> 2, wc = wid & 3, fr = lane & 15, fq = lane >> 4;
    const int K = g.K, nt = K / BK;
    unsigned voffA[2], voffB[2];
#pragma unroll
    for (int i = 0; i < 2; ++i) { int R, C; stage_rc(tid * 16 + i * 8192, R, C); const int Rb = Epi::PERM ? ((R & ~31) + perm32(R & 31)) : R;
        voffA[i] = (unsigned)(R * K + C) * 2u; voffB[i] = (unsigned)(Rb * K + C) * 2u; }
    const size_t kstep = (size_t)(BK * 2);
    const size_t hstep = (size_t)HALF * K * 2;
    const size_t tstep = 2 * hstep;
    const unsigned ldsw = (unsigned)wid * 1024u;
    const int aoff = lds_byte(wr * 64 + fr, fq * 8), boff = lds_byte(wc * 32 + fr, fq * 8);
#define PG8_SA(b, h) (((b) * 2 + (h)) * HTB)
#define PG8_SB(b, h) ((4 + (b) * 2 + (h)) * HTB)
#define PG8_STAGE(bufoff, gbase, voff) do { _Pragma("unroll") for (int _i = 0; _i < 2; ++_i) \
        __builtin_amdgcn_global_load_lds((const unsigned*)((const char*)(gbase) + (voff)[_i]), (PG8_LAS unsigned*)(lds + (bufoff) + ldsw + _i * 8192), 16, 0, 0); } while (0)
#define PG8_LDA(dst, b, h) do { _Pragma("unroll") for (int m = 0; m < 4; ++m) _Pragma("unroll") for (int k = 0; k < 2; ++k) dst[m][k] = *(const PG8_LAS bf16x8*)(lds + PG8_SA(b, h) + aoff + m * 2048 + k * 1024); } while (0)
#define PG8_LDB(dst, b, h) do { _Pragma("unroll") for (int n = 0; n < 2; ++n) _Pragma("unroll") for (int k = 0; k < 2; ++k) dst[n][k] = *(const PG8_LAS bf16x8*)(lds + PG8_SB(b, h) + boff + n * 2048 + k * 1024); } while (0)
#define PG8_MMA(ai, bj, At, Bt) do { __builtin_amdgcn_s_setprio(1); _Pragma("unroll") for (int m = 0; m < 4; ++m) _Pragma("unroll") for (int n = 0; n < 2; ++n) _Pragma("unroll") for (int k = 0; k < 2; ++k) \
        acc[ai][bj][m][n] = __builtin_amdgcn_mfma_f32_16x16x32_bf16(Bt[n][k], At[m][k], acc[ai][bj][m][n], 0, 0, 0); __builtin_amdgcn_s_setprio(0); } while (0)
#define PG8_WAIT_V(n) asm volatile("s_waitcnt vmcnt(" #n ")" ::: "memory")
#define PG8_WAIT_L(n) asm volatile("s_waitcnt lgkmcnt(" #n ")" ::: "memory")
#define PG8_BAR __builtin_amdgcn_s_barrier()
#define PG8_SCHED __builtin_amdgcn_sched_barrier(0)
    Unit cur, nxt; int ui = 0;
    if (!S.next(0, cur)) return;
    f32x4 acc[2][2][4][2];
#pragma unroll
    for (int a = 0; a < 2; ++a)
#pragma unroll
        for (int b = 0; b < 2; ++b)
#pragma unroll
            for (int m = 0; m < 4; ++m)
#pragma unroll
                for (int n = 0; n < 2; ++n) acc[a][b][m][n] = (f32x4){0.f, 0.f, 0.f, 0.f};
    bf16x8 At[4][2], B0[2][2], B1[2][2];
    const char* cA = (const char*)g.A + (size_t)cur.pm * tstep; const char* cB = (const char*)g.Bt + (size_t)cur.pn * tstep;
    S.a_ready(cur);
    if constexpr (SP2) {
        PG8_STAGE(PG8_SB(0, 0), cB, voffB); PG8_STAGE(PG8_SB(0, 1), cB + hstep, voffB); PG8_STAGE(PG8_SA(0, 0), cA, voffA); PG8_STAGE(PG8_SA(0, 1), cA + hstep, voffA);
        if (wr == 1) PG8_BAR;
        PG8_WAIT_V(2); PG8_BAR;
        PG8_STAGE(PG8_SB(1, 0), cB + kstep, voffB); PG8_STAGE(PG8_SA(1, 0), cA + kstep, voffA); PG8_STAGE(PG8_SB(1, 1), cB + hstep + kstep, voffB);
        PG8_WAIT_V(6); PG8_BAR;
    } else {
        PG8_STAGE(PG8_SB(0, 0), cB, voffB); PG8_STAGE(PG8_SA(0, 0), cA, voffA); PG8_STAGE(PG8_SB(0, 1), cB + hstep, voffB); PG8_STAGE(PG8_SA(0, 1), cA + hstep, voffA);
        if (wr == 1) PG8_BAR;
        PG8_WAIT_V(4); PG8_BAR;
        PG8_STAGE(PG8_SB(1, 0), cB + kstep, voffB); PG8_STAGE(PG8_SA(1, 0), cA + kstep, voffA); PG8_STAGE(PG8_SB(1, 1), cB + hstep + kstep, voffB);
        PG8_WAIT_V(6); PG8_BAR;
    }
    for (;;) {
        const bool has_next = S.next(ui + 1, nxt);
        const char* nA = has_next ? (const char*)g.A + (size_t)nxt.pm * tstep : cA; const char* nB = has_next ? (const char*)g.Bt + (size_t)nxt.pn * tstep : cB;
        for (int t = 0; t < nt; t += 2) {
            const bool last = (t == nt - 2);
            const char* a1 = cA + (size_t)(t + 1) * kstep;
            const char* a2 = last ? nA : cA + (size_t)(t + 2) * kstep; const char* b2 = last ? nB : cB + (size_t)(t + 2) * kstep;
            const char* a3 = a2 + kstep; const char* b3 = b2 + kstep;
            if (last && has_next) S.a_ready(nxt);
            if constexpr (SP2) {
            PG8_LDB(B0, 0, 0); PG8_LDB(B1, 0, 1); PG8_SCHED; PG8_LDA(At, 0, 0); PG8_STAGE(PG8_SA(1, 1), a1 + hstep, voffA);
            PG8_WAIT_V(8); PG8_WAIT_L(0); PG8_BAR; PG8_MMA(0, 0, At, B0); PG8_MMA(0, 1, At, B1); PG8_BAR; PG8_SCHED;
            PG8_LDA(At, 0, 1); PG8_STAGE(PG8_SB(0, 0), b2, voffB); PG8_STAGE(PG8_SB(0, 1), b2 + hstep, voffB); PG8_STAGE(PG8_SA(0, 0), a2, voffA);
            PG8_WAIT_V(8); PG8_WAIT_L(0); PG8_BAR; PG8_MMA(1, 0, At, B0); PG8_MMA(1, 1, At, B1); PG8_BAR; PG8_SCHED;
            PG8_LDB(B0, 1, 0); PG8_LDB(B1, 1, 1); PG8_SCHED; PG8_LDA(At, 1, 0); PG8_STAGE(PG8_SA(0, 1), a2 + hstep, voffA);
            PG8_WAIT_V(8); PG8_WAIT_L(0); PG8_BAR; PG8_MMA(0, 0, At, B0); PG8_MMA(0, 1, At, B1); PG8_BAR; PG8_SCHED;
            PG8_LDA(At, 1, 1); PG8_STAGE(PG8_SB(1, 0), b3, voffB); PG8_STAGE(PG8_SB(1, 1), b3 + hstep, voffB); PG8_STAGE(PG8_SA(1, 0), a3, voffA);
            PG8_WAIT_V(8); PG8_WAIT_L(0); PG8_BAR; PG8_MMA(1, 0, At, B0); PG8_MMA(1, 1, At, B1); PG8_BAR; PG8_SCHED;
            } else {
            PG8_LDB(B0, 0, 0); PG8_SCHED; PG8_LDA(At, 0, 0); PG8_STAGE(PG8_SA(1, 1), a1 + hstep, voffA);
            PG8_WAIT_L(8); PG8_BAR; PG8_WAIT_L(0); PG8_MMA(0, 0, At, B0); PG8_BAR; PG8_SCHED;
            PG8_LDB(B1, 0, 1); PG8_STAGE(PG8_SB(0, 0), b2, voffB);
            PG8_BAR; PG8_WAIT_L(0); PG8_MMA(0, 1, At, B1); PG8_BAR;
            PG8_LDA(At, 0, 1); PG8_STAGE(PG8_SA(0, 0), a2, voffA);
            PG8_BAR; PG8_WAIT_L(0); PG8_MMA(1, 0, At, B0); PG8_BAR; PG8_SCHED;
            PG8_STAGE(PG8_SB(0, 1), b2 + hstep, voffB);
            PG8_WAIT_V(6); PG8_BAR; PG8_MMA(1, 1, At, B1); PG8_BAR;
            PG8_LDB(B0, 1, 0); PG8_SCHED; PG8_LDA(At, 1, 0); PG8_STAGE(PG8_SA(0, 1), a2 + hstep, voffA);
            PG8_WAIT_L(8); PG8_BAR; PG8_WAIT_L(0); PG8_MMA(0, 0, At, B0); PG8_BAR; PG8_SCHED;
            PG8_LDB(B1, 1, 1); PG8_STAGE(PG8_SB(1, 0), b3, voffB);
            PG8_BAR; PG8_WAIT_L(0); PG8_MMA(0, 1, At, B1); PG8_BAR;
            PG8_LDA(At, 1, 1); PG8_STAGE(PG8_SA(1, 0), a3, voffA);
            PG8_BAR; PG8_WAIT_L(0); PG8_MMA(1, 0, At, B0); PG8_BAR; PG8_SCHED;
            PG8_STAGE(PG8_SB(1, 1), b3 + hstep, voffB);
            PG8_WAIT_V(6); PG8_BAR; PG8_MMA(1, 1, At, B1); PG8_BAR;
            }
        }
        if constexpr (ALIGN_EPI) { if (wr == 0) PG8_BAR; }
        if constexpr (!Epi::AFTER_DRAIN) { E(acc, cur, wr, wc, fr, fq); S.done(cur); }
        if (!has_next) break;
#pragma unroll
        for (int a = 0; a < 2; ++a)
#pragma unroll
            for (int b = 0; b < 2; ++b)
#pragma unroll
                for (int m = 0; m < 4; ++m)
#pragma unroll
                    for (int n = 0; n < 2; ++n) acc[a][b][m][n] = (f32x4){0.f, 0.f, 0.f, 0.f};
        cur = nxt; cA = nA; cB = nB; ++ui;
        if constexpr (ALIGN_EPI) { if (wr == 1) PG8_BAR; }
    }
    PG8_WAIT_V(0);
    if constexpr (!ALIGN_EPI) { if (wr == 0) PG8_BAR; }
    PG8_BAR;
    if constexpr (Epi::AFTER_DRAIN) { E.fused(acc, cur, wr, wc, fr, fq, lds, wid, lane); S.done(cur); }
#undef PG8_SA
#undef PG8_SB
#undef PG8_STAGE
#undef PG8_LDA
#undef PG8_LDB
#undef PG8_MMA
#undef PG8_WAIT_V
#undef PG8_WAIT_L
#undef PG8_BAR
#undef PG8_SCHED
}
}

namespace att {
#define LAS __attribute__((address_space(3)))
typedef short bf16x8 __attribute__((ext_vector_type(8)));
typedef short s16x4 __attribute__((ext_vector_type(4)));
typedef float f32x16 __attribute__((ext_vector_type(16)));
typedef float f32x4 __attribute__((ext_vector_type(4)));
typedef unsigned u32x4 __attribute__((ext_vector_type(4)));
typedef unsigned u32x2 __attribute__((ext_vector_type(2)));
typedef LAS unsigned char lchar;
typedef unsigned short bf16_t;
constexpr int MP = 32768, LDQ = 3072;
constexpr float LOG2E = 1.4426950408889634f;
constexpr float C2 = 0.125f * LOG2E;
constexpr float NEG_BIG = -1e30f;

struct Params {
    const bf16_t* qkv;
    const float *cdk, *cdv, *csk, *csv;
    bf16_t* mixed;
    unsigned* queue;
    float lam;
};

__device__ __forceinline__ int crow(int r, int hi) { return (r & 3) + 8 * (r >> 2) + 4 * hi; }
typedef float f32x2_t __attribute__((ext_vector_type(2))); typedef __bf16 bf16x2_t __attribute__((ext_vector_type(2)));
__device__ __forceinline__ unsigned cvtpk(float lo, float hi) { const f32x2_t v = {lo, hi}; const bf16x2_t b = __builtin_convertvector(v, bf16x2_t); return __builtin_bit_cast(unsigned, b); }
__device__ __forceinline__ u32x4 pack8(f32x4 a, f32x4 b) { u32x4 w; w.x = cvtpk(a[0], a[1]); w.y = cvtpk(a[2], a[3]); w.z = cvtpk(b[0], b[1]); w.w = cvtpk(b[2], b[3]); return w; }
__device__ __forceinline__ bf16x8 vfrag(const lchar* p0, const lchar* p1) {
    const s16x4 a = __builtin_bit_cast(s16x4, __builtin_amdgcn_ds_read_tr16_b64_v4i16((LAS s16x4*)p0));
    const s16x4 b = __builtin_bit_cast(s16x4, __builtin_amdgcn_ds_read_tr16_b64_v4i16((LAS s16x4*)p1));
    return (bf16x8){a[0], a[1], a[2], a[3], b[0], b[1], b[2], b[3]};
}
__device__ __forceinline__ bf16x8 pfrag(const f32x16& p, int s) {
    u32x4 w; w.x = cvtpk(p[8 * s + 0], p[8 * s + 1]); w.y = cvtpk(p[8 * s + 2], p[8 * s + 3]); w.z = cvtpk(p[8 * s + 4], p[8 * s + 5]); w.w = cvtpk(p[8 * s + 6], p[8 * s + 7]);
    return __builtin_bit_cast(bf16x8, w);
}
__device__ __forceinline__ int offKd(int row, int ch) { return row * 256 + ((ch ^ (row & 15)) << 4); }
__device__ __forceinline__ int offVd(int row, int ch) { return row * 256 + ((ch ^ (((row & 3) << 2) | ((row >> 2) & 3))) << 4); }
__device__ __forceinline__ int offKs(int row, int ch) { return row * 128 + ((ch ^ (row & 7)) << 4); }
__device__ __forceinline__ int offVs(int row, int ch) { return row * 128 + ((ch ^ (((row >> 1) & 1) << 2)) << 4); }

constexpr int DBUF = 32768;
constexpr int SBUF = 16384;

__device__ __forceinline__ void diff_sub(const lchar* Kb, const lchar* Vb, int sub, int map, const bf16x8 (&qf)[4], f32x16 (&O)[4],
                                         float& m0, float& l0, float dq, float sl2, int lane) {
    const int r32 = lane & 31, hi = lane >> 5;
    f32x16 s;
#pragma unroll
    for (int r = 0; r < 16; ++r) s[r] = -sl2 * __builtin_fabsf(dq - (float)((r & 3) + 8 * (r >> 2)));
    const int krow = sub * 32 + r32;
    bf16x8 kf[4];
#pragma unroll
    for (int ds = 0; ds < 4; ++ds) kf[ds] = *(const LAS bf16x8*)(Kb + offKd(krow, 8 * map + 2 * ds + hi));
    const int q4 = (lane & 15) >> 2, p = lane & 3, g1 = (lane >> 4) & 1;
    bf16x8 vf[2][4];
#pragma unroll
    for (int sk = 0; sk < 2; ++sk)
#pragma unroll
        for (int d = 0; d < 4; ++d) {
            const int ch = d * 4 + 2 * g1 + (p >> 1);
            const int ra = sub * 32 + 16 * sk + 4 * hi + q4, rb = ra + 8;
            vf[sk][d] = vfrag(Vb + offVd(ra, ch) + 8 * (p & 1), Vb + offVd(rb, ch) + 8 * (p & 1));
        }
#pragma unroll
    for (int ds = 0; ds < 4; ++ds) s = __builtin_amdgcn_mfma_f32_32x32x16_bf16(kf[ds], qf[ds], s, 0, 0, 0);
    float mx = s[0];
#pragma unroll
    for (int r = 1; r < 16; ++r) mx = __builtin_fmaxf(mx, s[r]);
    mx = __builtin_fmaxf(mx, __shfl_xor(mx, 32));
    const float n0 = __builtin_fmaxf(m0, mx);
    if (__any(n0 > m0 + 24.f)) {
        const float f0 = __builtin_amdgcn_exp2f(__builtin_fmaxf(m0 - n0, -200.f));
        l0 *= f0;
#pragma unroll
        for (int d = 0; d < 4; ++d)
#pragma unroll
            for (int r = 0; r < 16; ++r) O[d][r] *= f0;
        m0 = n0;
    }
    float a0 = 0.f;
#pragma unroll
    for (int r = 0; r < 16; ++r) { s[r] = __builtin_amdgcn_exp2f(__builtin_fmaxf(s[r] - m0, -200.f)); a0 += s[r]; }
    l0 += a0;
    bf16x8 p0[2];
    p0[0] = pfrag(s, 0); p0[1] = pfrag(s, 1);
#pragma unroll
    for (int sk = 0; sk < 2; ++sk)
#pragma unroll
        for (int d = 0; d < 4; ++d) O[d] = __builtin_amdgcn_mfma_f32_32x32x16_bf16(vf[sk][d], p0[sk], O[d], 0, 0, 0);
}

__device__ __forceinline__ u32x4 ld_f32x8_bf16(const float* p) { const f32x4 a = *(const f32x4*)p, b = *(const f32x4*)(p + 4); return pack8(a, b); }

template <bool SAMPLE>
__device__ __forceinline__ void diff_unit(lchar* lds, const Params& P, const LAS float* gt, int b, int h, int qb) {
    int tid_ = threadIdx.x; asm volatile("" : "+v"(tid_));
    const int tid = tid_, lane = tid & 63, wid = __builtin_amdgcn_readfirstlane(tid >> 6), r32 = lane & 31, hi = lane >> 5;
    const int map = wid & 1, qg = SAMPLE ? ((wid >> 1) & 1) : (wid >> 1);
    const int q0 = SAMPLE ? 0 : qb * 128;
    const size_t qrow_g = SAMPLE ? (size_t)MP + b * 64 + qg * 32 + r32 : (size_t)b * 2048 + q0 + qg * 32 + r32;
    const int qpos = SAMPLE ? 4096 + qg * 32 + r32 : q0 + qg * 32 + r32;
    const int ntiles = SAMPLE ? 65 : 2 * qb + 2;
    const int tw = SAMPLE ? 64 : (q0 + qg * 32) >> 6;
    const bool compute_wave = true;
    const bool epi_wave = SAMPLE ? (wid < 4) : true;
    const int ksub = wid >> 2;
    const float sl2 = __builtin_amdgcn_exp2f(-2.0f * (float)(h + 1)) * LOG2E;
    bf16x8 qf[4];
#pragma unroll
    for (int ds = 0; ds < 4; ++ds) qf[ds] = *(const bf16x8*)(P.qkv + qrow_g * LDQ + h * 128 + map * 64 + ds * 16 + hi * 8);
    f32x16 O[4];
#pragma unroll
    for (int d = 0; d < 4; ++d) O[d] = (f32x16){};
    float m0 = NEG_BIG, l0 = 0.f;

    auto kvbf = [&](int which, int t, int row, int ch) -> const bf16_t* {
        const size_t r = SAMPLE ? (size_t)MP + b * 64 + row : (size_t)b * 2048 + t * 64 + row;
        return P.qkv + r * LDQ + (which ? 1024 : 512) + h * 128 + ch * 8; };
    auto kvf32 = [&](int which, int t, int row, int ch) -> const float* { return (which ? P.cdv : P.cdk) + ((size_t)b * 4096 + t * 64 + row) * 512 + h * 128 + ch * 8; };
    {
        u32x4 rk[2], rv[2]; f32x4 fk[SAMPLE ? 4 : 1], fv[SAMPLE ? 4 : 1];
        auto tile_load = [&](int t) {
#pragma unroll
            for (int i = 0; i < 2; ++i) { const int idx = tid + 512 * i, row = idx >> 4, ch = idx & 15;
                if (SAMPLE && t < 64) { const float* pk = kvf32(0, t, row, ch); const float* pv = kvf32(1, t, row, ch);
                    fk[(2 * i) % (SAMPLE ? 4 : 1)] = __builtin_nontemporal_load((const f32x4*)pk); fk[(2 * i + 1) % (SAMPLE ? 4 : 1)] = __builtin_nontemporal_load((const f32x4*)(pk + 4)); fv[(2 * i) % (SAMPLE ? 4 : 1)] = __builtin_nontemporal_load((const f32x4*)pv); fv[(2 * i + 1) % (SAMPLE ? 4 : 1)] = __builtin_nontemporal_load((const f32x4*)(pv + 4)); }
                else { rk[i] = *(const u32x4*)kvbf(0, t, row, ch); rv[i] = *(const u32x4*)kvbf(1, t, row, ch); } } };
        auto tile_store = [&](int t, lchar* buf) {
#pragma unroll
            for (int i = 0; i < 2; ++i) { const int idx = tid + 512 * i, row = idx >> 4, ch = idx & 15;
                if (SAMPLE && t < 64) { rk[i] = pack8(fk[(2 * i) % (SAMPLE ? 4 : 1)], fk[(2 * i + 1) % (SAMPLE ? 4 : 1)]); rv[i] = pack8(fv[(2 * i) % (SAMPLE ? 4 : 1)], fv[(2 * i + 1) % (SAMPLE ? 4 : 1)]); }
                *(LAS u32x4*)(buf + offKd(row, ch)) = rk[i]; *(LAS u32x4*)(buf + 16384 + offVd(row, ch)) = rv[i]; } };
        tile_load(0); tile_store(0, lds);
        __syncthreads();
        for (int t = 0; t < ntiles; ++t) {
            const lchar* cur = lds + (t & 1) * DBUF; lchar* nxt = lds + ((t + 1) & 1) * DBUF;
            const bool more = (t + 1 < ntiles);
            if (more) tile_load(t + 1);
            if (SAMPLE) diff_sub(cur, cur + 16384, ksub, map, qf, O, m0, l0, (float)(qpos - t * 64 - ksub * 32 - 4 * hi), sl2, lane);
            else if (t <= tw) {
#pragma unroll
                for (int sub = 0; sub < 2; ++sub) diff_sub(cur, cur + 16384, sub, map, qf, O, m0, l0, (float)(qpos - t * 64 - sub * 32 - 4 * hi), sl2, lane);
            }
            if (more) tile_store(t + 1, nxt);
            __syncthreads();
        }
    }
    if (SAMPLE) {
        LAS float* cb2 = (LAS float*)lds + (wid & 3) * 4224 + lane;
        if (wid >= 4) { cb2[0] = m0; cb2[64] = l0;
#pragma unroll
            for (int d = 0; d < 4; ++d)
#pragma unroll
                for (int r = 0; r < 16; ++r) cb2[(2 + d * 16 + r) * 64] = O[d][r]; }
        __syncthreads();
        if (wid < 4) { const float mP = cb2[0], lP = cb2[64], mm = __builtin_fmaxf(m0, mP);
            const float f = __builtin_amdgcn_exp2f(__builtin_fmaxf(m0 - mm, -200.f)), fP = __builtin_amdgcn_exp2f(__builtin_fmaxf(mP - mm, -200.f));
            l0 = l0 * f + lP * fP; m0 = mm;
#pragma unroll
            for (int d = 0; d < 4; ++d)
#pragma unroll
                for (int r = 0; r < 16; ++r) O[d][r] = O[d][r] * f + cb2[(2 + d * 16 + r) * 64] * fP; }
        __syncthreads();
    }
    l0 += __shfl_xor(l0, 32);
    LAS float* xb = (LAS float*)lds + qg * 4096 + lane;
    if (epi_wave && map == 1) {
        const float i1 = P.lam / l0;
#pragma unroll
        for (int d = 0; d < 4; ++d)
#pragma unroll
            for (int r = 0; r < 16; ++r) xb[(d * 16 + r) * 64] = O[d][r] * i1;
    }
    __syncthreads();
    if (epi_wave && map == 0) {
        const float i0 = 1.0f / l0;
        float ss = 0.f;
#pragma unroll
        for (int d = 0; d < 4; ++d)
#pragma unroll
            for (int r = 0; r < 16; ++r) { const float o = O[d][r] * i0 - xb[(d * 16 + r) * 64]; O[d][r] = o; ss += o * o; }
        ss += __shfl_xor(ss, 32);
        const float rs = __builtin_amdgcn_rsqf(ss * (1.0f / 128.0f) + 1e-6f) * 0.8f;
        bf16_t* orow = P.mixed + qrow_g * 1024 + h * 128;
#pragma unroll
        for (int d = 0; d < 4; ++d)
#pragma unroll
            for (int G = 0; G < 4; ++G) {
                const int d0 = d * 32 + 8 * G + 4 * hi;
                u32x2 w; w.x = cvtpk(O[d][4 * G + 0] * rs * gt[d0 + 0], O[d][4 * G + 1] * rs * gt[d0 + 1]); w.y = cvtpk(O[d][4 * G + 2] * rs * gt[d0 + 2], O[d][4 * G + 3] * rs * gt[d0 + 3]);
                *(u32x2*)(orow + d0) = w;
            }
    }
}

__device__ __forceinline__ void sb_sub(const lchar* Kb, const lchar* Vb, int sub, bool diag, const bf16x8 (&qf)[4], f32x16 (&O)[2], float& R, int lane) {
    const int r32 = lane & 31, hi = lane >> 5;
    f32x16 z = {};
    const int krow = sub * 32 + r32;
    bf16x8 kf[4];
#pragma unroll
    for (int ds = 0; ds < 4; ++ds) kf[ds] = *(const LAS bf16x8*)(Kb + offKs(krow, 2 * ds + hi));
    const int q4 = (lane & 15) >> 2, p = lane & 3, g1 = (lane >> 4) & 1;
    bf16x8 vf[2][2];
#pragma unroll
    for (int s = 0; s < 2; ++s)
#pragma unroll
        for (int d = 0; d < 2; ++d) {
            const int ch = d * 4 + 2 * g1 + (p >> 1);
            const int ra = sub * 32 + 16 * s + 4 * hi + q4, rb = ra + 8;
            vf[s][d] = vfrag(Vb + offVs(ra, ch) + 8 * (p & 1), Vb + offVs(rb, ch) + 8 * (p & 1));
        }
#pragma unroll
    for (int ds = 0; ds < 4; ++ds) z = __builtin_amdgcn_mfma_f32_32x32x16_bf16(kf[ds], qf[ds], z, 0, 0, 0);
    f32x16 lk;
#pragma unroll
    for (int r = 0; r < 16; ++r) {
        const float zc = __builtin_amdgcn_fmed3f(z[r], -200.f, 80.f);
        float l = -__builtin_amdgcn_logf(1.0f + __builtin_amdgcn_exp2f(zc));
        float ls = zc + l;
        if (diag && !(crow(r, hi) < r32)) { l = 0.f; ls = NEG_BIG; }
        lk[r] = l; z[r] = ls;
    }
    float run = R;
#pragma unroll
    for (int G = 3; G >= 0; --G) {
        const float T = (lk[4 * G] + lk[4 * G + 1]) + (lk[4 * G + 2] + lk[4 * G + 3]);
        const float To = __shfl_xor(T, 32);
        const float a3 = run + (hi == 0 ? To : 0.f);
        const float a2 = a3 + lk[4 * G + 3], a1 = a2 + lk[4 * G + 2], a0 = a1 + lk[4 * G + 1];
        z[4 * G + 3] = __builtin_amdgcn_exp2f(__builtin_fmaxf(z[4 * G + 3] + a3, -200.f)); z[4 * G + 2] = __builtin_amdgcn_exp2f(__builtin_fmaxf(z[4 * G + 2] + a2, -200.f));
        z[4 * G + 1] = __builtin_amdgcn_exp2f(__builtin_fmaxf(z[4 * G + 1] + a1, -200.f)); z[4 * G + 0] = __builtin_amdgcn_exp2f(__builtin_fmaxf(z[4 * G + 0] + a0, -200.f));
        run += T + To;
    }
    R = run;
    bf16x8 pf[2]; pf[0] = pfrag(z, 0); pf[1] = pfrag(z, 1);
#pragma unroll
    for (int s = 0; s < 2; ++s)
#pragma unroll
        for (int d = 0; d < 2; ++d) O[d] = __builtin_amdgcn_mfma_f32_32x32x16_bf16(vf[s][d], pf[s], O[d], 0, 0, 0);
}

__device__ __forceinline__ void sb_unit(const bool SAMPLE, lchar* lds, const Params& P, int b, int h, int qb) {
    int tid_ = threadIdx.x; asm volatile("" : "+v"(tid_));
    const int tid = tid_, lane = tid & 63, wid = __builtin_amdgcn_readfirstlane(tid >> 6), r32 = lane & 31, hi = lane >> 5;
    const int q0 = SAMPLE ? 4096 : qb * 256;
    const int wq0 = q0 + (SAMPLE ? (wid & 1) : wid) * 32;
    const size_t qrow_g = SAMPLE ? (size_t)MP + b * 64 + (wid & 1) * 32 + r32 : (size_t)b * 2048 + wq0 + r32;
    const int thi = SAMPLE ? 64 : 4 * qb + 3;
    const int tw = wq0 >> 6, sw = (wq0 >> 5) & 1;
    const bool compute_wave = SAMPLE ? (wid < 2) : true;
    bf16x8 qf[4];
#pragma unroll
    for (int ds = 0; ds < 4; ++ds) qf[ds] = *(const bf16x8*)(P.qkv + qrow_g * LDQ + 1536 + h * 64 + ds * 16 + hi * 8);
    f32x16 O[2]; O[0] = (f32x16){}; O[1] = (f32x16){};
    float R = 0.f;
    auto compute = [&](int t, const lchar* cur) {
        if (t > tw) return;
        if (__all(R < -160.f)) return;
        if (t == tw) {
            if (sw == 1) { sb_sub(cur, cur + 8192, 1, true, qf, O, R, lane); sb_sub(cur, cur + 8192, 0, false, qf, O, R, lane); }
            else sb_sub(cur, cur + 8192, 0, true, qf, O, R, lane);
        } else { sb_sub(cur, cur + 8192, 1, false, qf, O, R, lane); sb_sub(cur, cur + 8192, 0, false, qf, O, R, lane); }
    };
    auto kvload = [&](int which, int t, int row, int ch) -> u32x4 {
        if (SAMPLE && t < 64) return ld_f32x8_bf16((which ? P.csv : P.csk) + ((size_t)b * 4096 + t * 64 + row) * 512 + h * 64 + ch * 8);
        const size_t r = SAMPLE ? (size_t)MP + b * 64 + row : (size_t)b * 2048 + t * 64 + row;
        return *(const u32x4*)(P.qkv + r * LDQ + (which ? 2560 : 2048) + h * 64 + ch * 8); };
    {
        const int row = tid >> 3, ch = tid & 7;
        u32x4 rk = kvload(0, thi, row, ch), rv = kvload(1, thi, row, ch);
        *(LAS u32x4*)(lds + offKs(row, ch)) = rk; *(LAS u32x4*)(lds + 8192 + offVs(row, ch)) = rv;
        __syncthreads();
        int par = 0;
        volatile LAS int* dflag = (volatile LAS int*)(lds + 131072 + 1600);
        for (int t = thi; t >= 0; --t, par ^= 1) {
            const lchar* cur = lds + par * SBUF; lchar* nxt = lds + (par ^ 1) * SBUF;
            if (t > 0) { rk = kvload(0, t - 1, row, ch); rv = kvload(1, t - 1, row, ch); }
            if (compute_wave) compute(t, cur);
            if (t > 0) { *(LAS u32x4*)(nxt + offKs(row, ch)) = rk; *(LAS u32x4*)(nxt + 8192 + offVs(row, ch)) = rv; }
            const int wdone = (!compute_wave || (t <= tw && __all(R < -160.f))) ? 1 : 0;
            if (lane == 0) dflag[par * 8 + wid] = wdone;
            __syncthreads();
            int alld = 1;
#pragma unroll
            for (int w = 0; w < 8; ++w) alld &= dflag[par * 8 + w];
            if (alld) break;
        }
    }
    if (compute_wave) {
        bf16_t* orow = P.mixed + qrow_g * 1024 + 512 + h * 64;
#pragma unroll
        for (int d = 0; d < 2; ++d)
#pragma unroll
            for (int G = 0; G < 4; ++G) {
                const int d0 = d * 32 + 8 * G + 4 * hi;
                u32x2 w; w.x = cvtpk(O[d][4 * G + 0], O[d][4 * G + 1]); w.y = cvtpk(O[d][4 * G + 2], O[d][4 * G + 3]);
                *(u32x2*)(orow + d0) = w;
            }
    }
}

constexpr int N_UNITS = 192 + 8 * 256;
__device__ __forceinline__ void attn_phase(lchar* lds, Params P, const float* subln_g, int u_base, int u_end) {
    LAS float* gt = (LAS float*)(lds + 131072 + 1024);
    volatile LAS int* slot = (volatile LAS int*)(lds + 131072 + 1536);
    if (threadIdx.x < 128) gt[threadIdx.x] = subln_g[threadIdx.x];
    __syncthreads();
    for (;;) {
        if (threadIdx.x == 0) *slot = u_base + (int)atomicAdd(P.queue, 1u);
        __syncthreads();
        const int u = __builtin_amdgcn_readfirstlane(*slot);
        __syncthreads();
        if (u >= u_end) break;
        if (u < 64) { diff_unit<true>(lds, P, gt, u >> 2, u & 3, 0); }
        else if (u < 192) { const int j = u - 64; sb_unit(true, lds, P, j >> 3, j & 7, 0); }
        else {
            const int j = u - 192, g = 7 - (j >> 8), k = j & 255;
            if (k < 128) { diff_unit<false>(lds, P, gt, (k & 63) >> 2, k & 3, 2 * g + 1 - (k >> 6)); }
            else { const int kk = k - 128; sb_unit(false, lds, P, kk >> 3, kk & 7, g); }
        }
    }
}
#undef LAS
}

#define GAS __attribute__((address_space(1)))
#define LAS __attribute__((address_space(3)))
typedef unsigned short bf16;
typedef unsigned v4u __attribute__((ext_vector_type(4)));
typedef float f32x4 __attribute__((ext_vector_type(4)));
constexpr int NWAVES = 8;
constexpr int MT = 33792, MP = 32768, DM = 1024, NIN = 3072, FF = 2816;
constexpr size_t MiB = 1u << 20;
constexpr size_t WS_CTL = 0;
constexpr size_t WS_WIN = 1 * MiB;
constexpr size_t WS_WOUT = 7 * MiB;
constexpr size_t WS_WGU = 9 * MiB;
constexpr size_t WS_WDN = 20 * MiB;
constexpr size_t WS_SSQ1 = 26 * MiB;
constexpr size_t WS_SSQ2 = 29 * MiB;
constexpr size_t WS_XN = 32 * MiB;
constexpr size_t WS_HB = 100 * MiB;
constexpr size_t WS_QKV = 168 * MiB;
constexpr size_t WS_CACHE = 368 * MiB;
constexpr size_t WS_END = 624 * MiB;
constexpr int RING_BYTES = 131072, LDS_BYTES = 147456;

__device__ __forceinline__ unsigned f2bf(float f) { unsigned u = __builtin_bit_cast(unsigned, f); return (u + 0x7fffu + ((u >> 16) & 1u)) >> 16; }
__device__ __forceinline__ unsigned pk2(float lo, float hi) { return f2bf(lo) | (f2bf(hi) << 16); }
__device__ __forceinline__ float wave_sum(float v) {
#pragma unroll
    for (int o = 1; o < 64; o <<= 1) v += __shfl_xor(v, o);
    return v;
}
__device__ __forceinline__ void transpose_item(const float* W, int K, int N, bf16* WT, int k0, int n0, int orow0, const float* kscale, LAS float* scr, int lane) {
#pragma unroll 8
    for (int i = 0; i < 32; ++i) { const int kk = 2 * i + (lane >> 5); float v = W[(size_t)(k0 + kk) * N + n0 + (lane & 31)]; if (kscale) v *= kscale[k0 + kk]; scr[kk * 33 + (lane & 31)] = v; }
    asm volatile("s_waitcnt lgkmcnt(0)" ::: "memory");
    const int c = lane & 7;
#pragma unroll
    for (int j = 0; j < 4; ++j) { const int n = (lane >> 3) + 8 * j; const LAS float* s = scr + (8 * c) * 33 + n;
        v4u o; o.x = pk2(s[0 * 33], s[1 * 33]); o.y = pk2(s[2 * 33], s[3 * 33]); o.z = pk2(s[4 * 33], s[5 * 33]); o.w = pk2(s[6 * 33], s[7 * 33]);
        *(v4u*)(WT + (size_t)(orow0 + n) * K + k0 + 8 * c) = o; }
    asm volatile("s_waitcnt lgkmcnt(0)" ::: "memory");
}

#define XB_TMO      128
#define XB_XCNT(j)  (256  + 64 * (j))
#define XB_XSUB(j)  (1280 + 64 * (j))
#define XB_XGEN(j)  (2304 + 64 * (j))
#define XB_TOP      3328
#define XB_TOPGEN   3392
#define XCD_BAR_WORDS 3456
#define XB_SPIN_CAP (1u << 18)

__device__ __forceinline__ unsigned xb_ld(unsigned* p)              { return __hip_atomic_load(p, __ATOMIC_RELAXED, __HIP_MEMORY_SCOPE_AGENT); }
__device__ __forceinline__ unsigned xb_add(unsigned* p, unsigned v) { return __hip_atomic_fetch_add(p, v, __ATOMIC_RELAXED, __HIP_MEMORY_SCOPE_AGENT); }
__device__ __forceinline__ unsigned xb_xcc_id() { return (unsigned)__builtin_amdgcn_s_getreg((3 << 11) | 20) & 0xFu; }
#define XB_SPIN(cond, bar) do { unsigned _sp = 0; while (cond) { __builtin_amdgcn_s_sleep(1); \
    if ((++_sp & 255u) == 0u) { if (xb_ld(&(bar)[XB_TMO])) break; if (_sp > XB_SPIN_CAP) { atomicAdd(&(bar)[XB_TMO], 1u); break; } } } } while (0)

struct XcdBarrier {
    unsigned* bar; unsigned x;
    volatile LAS unsigned* st;
};

__device__ __forceinline__ XcdBarrier xcd_barrier_post(unsigned* bar, volatile LAS unsigned* st) {
    XcdBarrier b; b.bar = bar; b.x = xb_xcc_id(); b.st = st;
    if (threadIdx.x == 0) (void)xb_add(&bar[XB_XCNT(b.x)], 1u);
    return b;
}
__device__ __forceinline__ void xcd_barrier_complete(unsigned* bar, unsigned x, unsigned& nloc, unsigned& nx) {
    const unsigned G = gridDim.x * gridDim.y * gridDim.z;
    unsigned sum, cnt, mine, sp = 0u;
    for (;;) {
        sum = 0u; cnt = 0u; mine = 0u;
#pragma unroll
        for (unsigned j = 0; j < 16; ++j) { const unsigned c = xb_ld(&bar[XB_XCNT(j)]); sum += c; cnt += (c > 0u) ? 1u : 0u; mine = (j == x) ? c : mine; }
        if (sum == G) break;
        __builtin_amdgcn_s_sleep(1);
        if ((++sp & 255u) == 0u) { if (xb_ld(&bar[XB_TMO])) break; if (sp > XB_SPIN_CAP) { atomicAdd(&bar[XB_TMO], 1u); break; } }
    }
    nloc = mine > 0u ? mine : 1u; nx = cnt > 0u ? cnt : 1u;
}

__device__ __forceinline__ void xcd_barrier(const XcdBarrier& b) {
    asm volatile("s_waitcnt vmcnt(0)" ::: "memory");
    __syncthreads();
    if (threadIdx.x == 0) {
        unsigned* bar = b.bar;
        __builtin_amdgcn_s_waitcnt(0);
        unsigned nloc = b.st[0], nx = b.st[1];
        if (nloc == 0u) { xcd_barrier_complete(bar, b.x, nloc, nx); b.st[0] = nloc; b.st[1] = nx; }
        const unsigned old = xb_add(&bar[XB_XSUB(b.x)], 1u);
        const unsigned gen = old / nloc;
        if (old + 1u == (gen + 1u) * nloc) {
            __builtin_amdgcn_fence(__ATOMIC_RELEASE, "agent");
            asm volatile("s_waitcnt vmcnt(0)" ::: "memory");
            const unsigned og = xb_add(&bar[XB_TOP], 1u);
            const unsigned tg = og / nx;
            if (og + 1u == (tg + 1u) * nx) xb_add(&bar[XB_TOPGEN], 1u);
            else XB_SPIN(xb_ld(&bar[XB_TOPGEN]) == tg, bar);
            __builtin_amdgcn_fence(__ATOMIC_ACQUIRE, "agent");
            xb_add(&bar[XB_XGEN(b.x)], 1u);
            asm volatile("s_waitcnt vmcnt(0)" ::: "memory");
        } else {
            XB_SPIN(xb_ld(&bar[XB_XGEN(b.x)]) == gen, bar);
            __builtin_amdgcn_fence(__ATOMIC_ACQUIRE, "agent");
            asm volatile("s_waitcnt vmcnt(0)" ::: "memory");
        }
    }
    __syncthreads();
}


struct Args {
    const float* in[19]; float* out; unsigned char* ws; int ph_lo, ph_hi; int isz[20];
};

__global__ void __launch_bounds__(NWAVES * 64, 2) fwd_kernel(Args args) {
    extern __shared__ __attribute__((aligned(16))) unsigned char lds_raw[];
    LAS unsigned char* lds = (LAS unsigned char*)lds_raw;
    const int tid = threadIdx.x, lane = tid & 63, wave = __builtin_amdgcn_readfirstlane(tid >> 6);
    const int G = gridDim.x;
    unsigned char* ws = args.ws;
    const float* xp = args.in[0]; const float* xs = args.in[1];
    float* out = args.out;
    bf16* Win_t = (bf16*)(ws + WS_WIN); bf16* Wout_t = (bf16*)(ws + WS_WOUT); bf16* Wgu_t = (bf16*)(ws + WS_WGU); bf16* Wdn_t = (bf16*)(ws + WS_WDN);
    bf16* XN = (bf16*)(ws + WS_XN); bf16* HB = (bf16*)(ws + WS_HB); bf16* QKV = (bf16*)(ws + WS_QKV); bf16* ACT = (bf16*)(ws + WS_QKV);
    float* SSQ1 = (float*)(ws + WS_SSQ1); float* SSQ2 = (float*)(ws + WS_SSQ2);
    const int lo = args.ph_lo, hi = args.ph_hi;
#define IN(k) (lo <= (k) && (k) < hi)
    unsigned* barw = (unsigned*)(ws + WS_CTL) + 1024;
    volatile LAS unsigned* MISC = (volatile LAS unsigned*)(lds + 131072 + 320);
    if (tid == 0) { MISC[8] = 0u; MISC[9] = 0u; }
    __syncthreads();
    XcdBarrier xbar = xcd_barrier_post(barw, MISC + 8);
    if (args.ph_lo == 0x7fffffff) cg::this_grid().sync();
#define SEAM(k) do { if (IN(k) && IN((k) + 1)) { xcd_barrier(xbar); } } while (0)

    if (IN(0)) {
        if (blockIdx.x == 0 && tid == 0) { __hip_atomic_store((unsigned*)(ws + WS_CTL), 0u, __ATOMIC_RELAXED, __HIP_MEMORY_SCOPE_AGENT); __hip_atomic_store((unsigned*)(ws + WS_CTL) + 64, 0u, __ATOMIC_RELAXED, __HIP_MEMORY_SCOPE_AGENT); }
        LAS float* scr = (LAS float*)(lds + wave * 16384);
        const int gw = blockIdx.x * NWAVES + wave, NGW = G * NWAVES;
        constexpr int I_IN = 16 * 96, I_OUT = 16 * 32, I_G = 16 * 88, I_D = 44 * 32;
        constexpr int NITEMS = I_IN + I_OUT + 2 * I_G + I_D;
        const float* w_in = args.in[7]; const float* w_out = args.in[13]; const float* g_ffn = args.in[14];
        const float* w_gate = args.in[15]; const float* w_up = args.in[16]; const float* w_down = args.in[17];
        for (int it = gw; it < NITEMS; it += NGW) {
            int r = it;
            if (r < I_IN) { const int kb = r / 96, nb = r % 96; transpose_item(w_in, DM, NIN, Win_t, 64 * kb, 32 * nb, 32 * nb, nullptr, scr, lane); continue; } r -= I_IN;
            if (r < I_OUT) { const int kb = r / 32, nb = r % 32; transpose_item(w_out, DM, DM, Wout_t, 64 * kb, 32 * nb, 32 * nb, nullptr, scr, lane); continue; } r -= I_OUT;
            if (r < I_G) { const int kb = r / 88, nb = r % 88, n0 = 32 * nb; transpose_item(w_gate, DM, FF, Wgu_t, 64 * kb, n0, 256 * (n0 >> 7) + (n0 & 127), g_ffn, scr, lane); continue; } r -= I_G;
            if (r < I_G) { const int kb = r / 88, nb = r % 88, n0 = 32 * nb; transpose_item(w_up, DM, FF, Wgu_t, 64 * kb, n0, 256 * (n0 >> 7) + 128 + (n0 & 127), g_ffn, scr, lane); continue; } r -= I_G;
            { const int kb = r / 32, nb = r % 32; transpose_item(w_down, FF, DM, Wdn_t, 64 * kb, 32 * nb, 32 * nb, nullptr, scr, lane); }
        }
        const float* g_attn = args.in[6];
        f32x4 gv[4];
#pragma unroll
        for (int j = 0; j < 4; ++j) gv[j] = ((const f32x4*)g_attn)[lane + 64 * j];
        for (int m = gw; m < MT; m += NGW) {
            const float* xrow = (m < MP) ? xp + (size_t)m * DM : xs + (size_t)(m - MP) * DM;
            const f32x4* xr = (const f32x4*)xrow + lane;
            f32x4 v[4]; float s = 0.f;
#pragma unroll
            for (int j = 0; j < 4; ++j) { v[j] = xr[64 * j]; s += (v[j].x * v[j].x + v[j].y * v[j].y) + (v[j].z * v[j].z + v[j].w * v[j].w); }
            const float rstd = __builtin_amdgcn_rsqf(wave_sum(s) * (1.f / DM) + 1e-6f);
            unsigned long long* o8 = (unsigned long long*)(XN + (size_t)m * DM) + lane;
#pragma unroll
            for (int j = 0; j < 4; ++j) { const f32x4 w = v[j] * rstd * gv[j]; o8[64 * j] = (unsigned long long)pk2(w.x, w.y) | ((unsigned long long)pk2(w.z, w.w) << 32); }
        }
    }
    SEAM(0);

    if (IN(1)) {
        pg8::Gemm g{XN, Win_t, MT, NIN, DM}; pg8::StaticOrder S; S.init(MT, NIN, G, (int)blockIdx.x);
        pg8::EpiQKV E{QKV, out, att::C2};
        pg8::gemm_phase<pg8::EpiQKV, pg8::StaticOrder, true, true>(lds, g, S, E);
    }
    SEAM(1);

    if (IN(2)) {
        const float d1 = wave_sum(args.in[8][lane] * args.in[9][lane]), d2 = wave_sum(args.in[10][lane] * args.in[11][lane]);
        att::Params P;
        P.qkv = QKV; P.cdk = args.in[2]; P.cdv = args.in[3]; P.csk = args.in[4]; P.csv = args.in[5]; P.mixed = XN; P.queue = (unsigned*)(ws + WS_CTL);
        P.lam = __expf(d1) - __expf(d2) + 0.2f;
        att::attn_phase(lds, P, args.in[12], 0, att::N_UNITS);
    }
    SEAM(2);

    if (IN(3)) {
        pg8::Gemm g{XN, Wout_t, MT, DM, DM};
        pg8::StaticOrder S; S.init(MT, DM, G, (int)blockIdx.x);
        pg8::EpiRes E{xp, xs, out, HB, SSQ1};
        pg8::gemm_phase<pg8::EpiRes, pg8::StaticOrder, true, true>(lds, g, S, E);
    }
    SEAM(3);

    if (IN(4)) {
        pg8::Gemm g{HB, Wgu_t, MT, 2 * FF, DM}; pg8::StaticOrder S; S.init(MT, 2 * FF, G, (int)blockIdx.x);
        pg8::EpiSwiGLU E{ACT, SSQ1};
        pg8::gemm_phase<pg8::EpiSwiGLU, pg8::StaticOrder, true, true>(lds, g, S, E);
    }
    SEAM(4);

    if (IN(5)) {
        pg8::Gemm g{ACT, Wdn_t, MT, DM, FF}; pg8::StaticOrder S; S.init(MT, DM, G, (int)blockIdx.x);
        pg8::EpiRes E{out, out + (size_t)MP * DM, out, nullptr, SSQ2};
        pg8::gemm_phase<pg8::EpiRes, pg8::StaticOrder, true, true>(lds, g, S, E);
    }
    SEAM(5);

    if (IN(6)) {
        const int gw = blockIdx.x * NWAVES + wave, NGW = G * NWAVES;
        const float* g_fin = args.in[18];
        f32x4 gv[4];
#pragma unroll
        for (int j = 0; j < 4; ++j) gv[j] = ((const f32x4*)g_fin)[lane + 64 * j];
        for (int m = gw; m < MT; m += NGW) {
            const float pss = (lane < 16) ? SSQ2[((size_t)(lane >> 2) * MT + m) * 4 + (lane & 3)] : 0.f;
            const float rstd = __builtin_amdgcn_rsqf(wave_sum(pss) * (1.f / DM) + 1e-6f);
            f32x4* yr = (f32x4*)(out + (size_t)m * DM) + lane;
#pragma unroll
            for (int j = 0; j < 4; ++j) { const f32x4 o = yr[64 * j] * rstd * gv[j]; __builtin_nontemporal_store(o, &yr[64 * j]); }
        }
    }
#undef IN
#undef SEAM
}

#ifndef MK_N_LAUNCHES
#define MK_N_LAUNCHES 1
#endif
extern "C" void kernel_launch(void* const* d_in, const int* in_sizes, int n_in, void* d_out, int out_size, void* d_ws, size_t ws_size, hipStream_t stream) {
    static int grid = 0;
    if (grid == 0) {
        if (n_in != 19 || ws_size < WS_END) { fprintf(stderr, "kernel_launch: unexpected n_in %d or ws_size %zu\n", n_in, ws_size); grid = -1; return; }
        int dev = 0, cus = 0, per_cu = 0;
        hipGetDevice(&dev); hipDeviceGetAttribute(&cus, hipDeviceAttributeMultiprocessorCount, dev);
        hipFuncSetAttribute((const void*)fwd_kernel, hipFuncAttributeMaxDynamicSharedMemorySize, LDS_BYTES);
        hipOccupancyMaxActiveBlocksPerMultiprocessor(&per_cu, (const void*)fwd_kernel, NWAVES * 64, LDS_BYTES);
        if (per_cu < 1) { fprintf(stderr, "kernel_launch: occupancy query says %d blocks per CU\n", per_cu); per_cu = 1; }
        (void)hipGetLastError();
        grid = cus * per_cu;
    }
    if (grid < 0) return;
    (void)hipMemsetAsync((char*)d_ws + WS_CTL, 0, 32768, stream);
    Args a{};
    for (int i = 0; i < 19; ++i) a.in[i] = (const float*)d_in[i];
    a.out = (float*)d_out; a.ws = (unsigned char*)d_ws; for (int i = 0; i < 19; ++i) a.isz[i] = in_sizes[i];
    if (MK_N_LAUNCHES == 1) {
        a.ph_lo = 0; a.ph_hi = 7;
        void* kargs[] = {&a};
        hipError_t e = hipLaunchCooperativeKernel((const void*)fwd_kernel, dim3(grid), dim3(NWAVES * 64), kargs, LDS_BYTES, stream);
        if (e != hipSuccess) fprintf(stderr, "cooperative launch failed: %s (grid %d)\n", hipGetErrorString(e), grid);
    } else {
        for (int ph = 0; ph < 7; ++ph) { a.ph_lo = ph; a.ph_hi = ph + 1; hipLaunchKernelGGL(fwd_kernel, dim3(grid), dim3(NWAVES * 64), LDS_BYTES, stream, a); }
    }
}
```

```cpp
#include <hip/hip_runtime.h>
#include <hip/hip_cooperative_groups.h>
#include <cstdio>
#include <cstdint>
namespace cg = cooperative_groups;
namespace pg8 {
#define PG8_LAS __attribute__((address_space(3)))
typedef unsigned short bf16_t;
typedef short bf16x8 __attribute__((ext_vector_type(8)));
typedef float f32x4 __attribute__((ext_vector_type(4)));
typedef unsigned u32x4 __attribute__((ext_vector_type(4)));
constexpr int BM = 256, BK = 64, HALF = 128, HTB = HALF * BK * 2  , STAGE_BYTES = 8 * HTB, NXCD = 8, WGM = 8;

__host__ __device__ __forceinline__ int lds_byte(int r, int c) { const int st = (r >> 4) * 2 + (c >> 5), rr = r & 15, cc = c & 31, ob = rr * 64 + cc * 2; return st * 1024 + (ob ^ (((ob >> 9) & 1) << 5)); }
__host__ __device__ __forceinline__ void stage_rc(int b, int& R, int& C) { const int st = b / 1024, sb = b % 1024, swz = sb ^ (((sb >> 9) & 1) << 5); R = (st >> 1) * 16 + swz / 64; C = (st & 1) * 32 + (swz % 64) / 2; }
__host__ __device__ __forceinline__ int perm32(int rho) { const int n = rho >> 4, i = rho & 15; return 8 * (i >> 2) + 4 * n + (i & 3); }

struct Unit { int pm, pn; };
struct Gemm { const bf16_t* A; const bf16_t* Bt; int M, N, K; };

struct StaticOrder {
    int nM, nN, nwg, G, c;
    __host__ __device__ void init(int M, int N, int G_, int c_) { nM = M / BM; nN = N / BM; nwg = nM * nN; G = G_; c = c_; }
    __host__ __device__ bool next(int i, Unit& u) const {
        const long L = (long)i * G + c; if (L >= nwg) return false;
        int wgid = (int)L; { const int q = nwg / NXCD, r = nwg % NXCD, xcd = wgid % NXCD, off = wgid / NXCD; wgid = (xcd < r ? xcd * (q + 1) : r * (q + 1) + (xcd - r) * q) + off; }
        const int nig = WGM * nN, gid = wgid / nig, fm = gid * WGM, gsz = (nM - fm) < WGM ? (nM - fm) : WGM;
        u.pm = fm + ((wgid % nig) % gsz); u.pn = (wgid % nig) / gsz; return true;
    }
    __device__ __forceinline__ void a_ready(const Unit&) const {}
    __device__ __forceinline__ void done(const Unit&) const {}
};

__device__ __forceinline__ unsigned cvt_pk_bf16(float lo, float hi) { unsigned r; asm volatile("v_cvt_pk_bf16_f32 %0, %1, %2" : "=v"(r) : "v"(lo), "v"(hi)); return r; }
typedef float f32x2 __attribute__((ext_vector_type(2)));

constexpr int MT = 33792;
constexpr int MP = 32768;
constexpr size_t OFF_PKV = (size_t)MT * 1024;
constexpr size_t OFF_SKV = OFF_PKV + 4ull * MP * 512;
constexpr float RMS_EPS = 1e-6f;
constexpr float LOG2E = 1.4426950408889634f;
typedef float f32x2 __attribute__((ext_vector_type(2)));

struct EpiQKV {
    static constexpr bool PERM = true, AFTER_DRAIN = false;
    bf16_t* qkv; float* out; float qscale;
    __device__ __forceinline__ void operator()(const f32x4 (&acc)[2][2][4][2], const Unit& u, int wr, int wc, int fr, int fq) const {
        const int seg = u.pn >> 1;
        const bool isq = (seg == 0) || (seg == 3);
        const float sc = isq ? qscale : 1.f;
        const int row0 = u.pm * BM + wr * 64 + fr, col0 = u.pn * BM + wc * 32 + 8 * fq;
        const int oi = (seg == 1) ? 0 : (seg == 2) ? 1 : (seg == 4) ? 2 : 3;
        const bool prompt = u.pm < (MP / BM);
        float* obase = prompt ? out + OFF_PKV + (size_t)oi * ((size_t)MP * 512) : out + OFF_SKV + (size_t)oi * (1024 * 512);
        const int orow0 = prompt ? row0 : row0 - MP;
        const int ocol0 = (u.pn & 1) * 256 + wc * 32 + 8 * fq;
#pragma unroll
        for (int ai = 0; ai < 2; ++ai)
#pragma unroll
            for (int m = 0; m < 4; ++m) {
                const int rr = ai * HALF + m * 16;
#pragma unroll
                for (int bj = 0; bj < 2; ++bj) {
                    const f32x4 v0 = acc[ai][bj][m][0], v1 = acc[ai][bj][m][1];
                    if (!isq) { float* op = obase + (size_t)(orow0 + rr) * 512 + ocol0 + bj * HALF; __builtin_nontemporal_store(v0, (f32x4*)op); __builtin_nontemporal_store(v1, (f32x4*)(op + 4)); }
                    u32x4 w; w.x = cvt_pk_bf16(v0[0] * sc, v0[1] * sc); w.y = cvt_pk_bf16(v0[2] * sc, v0[3] * sc); w.z = cvt_pk_bf16(v1[0] * sc, v1[1] * sc); w.w = cvt_pk_bf16(v1[2] * sc, v1[3] * sc);
                    *(u32x4*)(qkv + (size_t)(row0 + rr) * 3072 + col0 + bj * HALF) = w;
                }
            }
    }
};

struct EpiRes {
    static constexpr bool PERM = true, AFTER_DRAIN = false;
    const float* bp; const float* bs; float* Y; bf16_t* hb; float* ssq;
    __device__ __forceinline__ void operator()(const f32x4 (&acc)[2][2][4][2], const Unit& u, int wr, int wc, int fr, int fq) const {
        const int row0 = u.pm * BM + wr * 64 + fr, col0 = u.pn * BM + wc * 32 + 8 * fq;
        const bool prompt = u.pm < (MP / BM);
#pragma unroll
        for (int ai = 0; ai < 2; ++ai)
#pragma unroll
            for (int m = 0; m < 4; ++m) {
                const int row = row0 + ai * HALF + m * 16;
                const float* b = prompt ? bp + (size_t)row * 1024 : bs + (size_t)(row - MP) * 1024;
                float s = 0.f;
#pragma unroll
                for (int bj = 0; bj < 2; ++bj) {
                    const int col = col0 + bj * HALF;
                    const f32x4 v0 = acc[ai][bj][m][0] + *(const f32x4*)(b + col), v1 = acc[ai][bj][m][1] + *(const f32x4*)(b + col + 4);
                    float* yp = Y + (size_t)row * 1024 + col; *(f32x4*)yp = v0; *(f32x4*)(yp + 4) = v1;
                    if (hb) { u32x4 w; w.x = cvt_pk_bf16(v0[0], v0[1]); w.y = cvt_pk_bf16(v0[2], v0[3]); w.z = cvt_pk_bf16(v1[0], v1[1]); w.w = cvt_pk_bf16(v1[2], v1[3]);
                        *(u32x4*)(hb + (size_t)row * 1024 + col) = w; }
                    s += (v0[0] * v0[0] + v0[1] * v0[1]) + (v0[2] * v0[2] + v0[3] * v0[3]) + (v1[0] * v1[0] + v1[1] * v1[1]) + (v1[2] * v1[2] + v1[3] * v1[3]);
                }
                s += __shfl_xor(s, 16); s += __shfl_xor(s, 32);
                if (fq == 0) ssq[((size_t)u.pn * MT + row) * 4 + wc] = s;
            }
    }
};

struct EpiSwiGLU {
    static constexpr bool PERM = true, AFTER_DRAIN = false;
    bf16_t* act; const float* ssq;
    __device__ __forceinline__ void operator()(const f32x4 (&acc)[2][2][4][2], const Unit& u, int wr, int wc, int fr, int fq) const {
        const int row0 = u.pm * BM + wr * 64 + fr, col0 = u.pn * HALF + wc * 32 + 8 * fq;
#pragma unroll
        for (int ai = 0; ai < 2; ++ai)
#pragma unroll
            for (int m = 0; m < 4; ++m) {
                const int row = row0 + ai * HALF + m * 16;
                const f32x4 a = *(const f32x4*)(ssq + (size_t)row * 4), b = *(const f32x4*)(ssq + ((size_t)MT + row) * 4), c = *(const f32x4*)(ssq + ((size_t)2 * MT + row) * 4), d = *(const f32x4*)(ssq + ((size_t)3 * MT + row) * 4);
                const float tot = ((a[0] + a[1]) + (a[2] + a[3])) + ((b[0] + b[1]) + (b[2] + b[3])) + ((c[0] + c[1]) + (c[2] + c[3])) + ((d[0] + d[1]) + (d[2] + d[3]));
                const float rstd = __builtin_amdgcn_rsqf(tot * (1.0f / 1024.0f) + RMS_EPS);
                float o[8];
#pragma unroll
                for (int n = 0; n < 2; ++n)
#pragma unroll
                    for (int i = 0; i < 4; ++i) {
                        const float g = acc[ai][0][m][n][i] * rstd, up = acc[ai][1][m][n][i] * rstd;
                        o[n * 4 + i] = g * __builtin_amdgcn_rcpf(1.f + __builtin_amdgcn_exp2f(__builtin_fmaxf(-g * LOG2E, -126.f))) * up;
                    }
                u32x4 w; w.x = cvt_pk_bf16(o[0], o[1]); w.y = cvt_pk_bf16(o[2], o[3]); w.z = cvt_pk_bf16(o[4], o[5]); w.w = cvt_pk_bf16(o[6], o[7]);
                *(u32x4*)(act + (size_t)row * 2816 + col0) = w;
            }
    }
};
template <class Epi, class Sched, bool ALIGN_EPI = false, bool SP2 = false>
__device__ __forceinline__ void gemm_phase(PG8_LAS unsigned char* lds, const Gemm g, const Sched& S, const Epi& E) {
    const int tid = threadIdx.x, wid = __builtin_amdgcn_readfirstlane(tid >> 6), lane = tid & 63, wr = wid >> 2, wc = wid & 3, fr = lane & 15, fq = lane >> 4;
    const int K = g.K, nt = K / BK;
    unsigned voffA[2], voffB[2];
#pragma unroll
    for (int i = 0; i < 2; ++i) { int R, C; stage_rc(tid * 16 + i * 8192, R, C); const int Rb = Epi::PERM ? ((R & ~31) + perm32(R & 31)) : R;
        voffA[i] = (unsigned)(R * K + C) * 2u; voffB[i] = (unsigned)(Rb * K + C) * 2u; }
    const size_t kstep = (size_t)(BK * 2);
    const size_t hstep = (size_t)HALF * K * 2;
    const size_t tstep = 2 * hstep;
    const unsigned ldsw = (unsigned)wid * 1024u;
    const int aoff = lds_byte(wr * 64 + fr, fq * 8), boff = lds_byte(wc * 32 + fr, fq * 8);
#define PG8_SA(b, h) (((b) * 2 + (h)) * HTB)
#define PG8_SB(b, h) ((4 + (b) * 2 + (h)) * HTB)
#define PG8_STAGE(bufoff, gbase, voff) do { _Pragma("unroll") for (int _i = 0; _i < 2; ++_i) \
        __builtin_amdgcn_global_load_lds((const unsigned*)((const char*)(gbase) + (voff)[_i]), (PG8_LAS unsigned*)(lds + (bufoff) + ldsw + _i * 8192), 16, 0, 0); } while (0)
#define PG8_LDA(dst, b, h) do { _Pragma("unroll") for (int m = 0; m < 4; ++m) _Pragma("unroll") for (int k = 0; k < 2; ++k) dst[m][k] = *(const PG8_LAS bf16x8*)(lds + PG8_SA(b, h) + aoff + m * 2048 + k * 1024); } while (0)
#define PG8_LDB(dst, b, h) do { _Pragma("unroll") for (int n = 0; n < 2; ++n) _Pragma("unroll") for (int k = 0; k < 2; ++k) dst[n][k] = *(const PG8_LAS bf16x8*)(lds + PG8_SB(b, h) + boff + n * 2048 + k * 1024); } while (0)
#define PG8_MMA(ai, bj, At, Bt) do { __builtin_amdgcn_s_setprio(1); _Pragma("unroll") for (int m = 0; m < 4; ++m) _Pragma("unroll") for (int n = 0; n < 2; ++n) _Pragma("unroll") for (int k = 0; k < 2; ++k) \
        acc[ai][bj][m][n] = __builtin_amdgcn_mfma_f32_16x16x32_bf16(Bt[n][k], At[m][k], acc[ai][bj][m][n], 0, 0, 0); __builtin_amdgcn_s_setprio(0); } while (0)
#define PG8_WAIT_V(n) asm volatile("s_waitcnt vmcnt(" #n ")" ::: "memory")
#define PG8_WAIT_L(n) asm volatile("s_waitcnt lgkmcnt(" #n ")" ::: "memory")
#define PG8_BAR __builtin_amdgcn_s_barrier()
#define PG8_SCHED __builtin_amdgcn_sched_barrier(0)
    Unit cur, nxt; int ui = 0;
    if (!S.next(0, cur)) return;
    f32x4 acc[2][2][4][2];
#pragma unroll
    for (int a = 0; a < 2; ++a)
#pragma unroll
        for (int b = 0; b < 2; ++b)
#pragma unroll
            for (int m = 0; m < 4; ++m)
#pragma unroll
                for (int n = 0; n < 2; ++n) acc[a][b][m][n] = (f32x4){0.f, 0.f, 0.f, 0.f};
    bf16x8 At[4][2], B0[2][2], B1[2][2];
    const char* cA = (const char*)g.A + (size_t)cur.pm * tstep; const char* cB = (const char*)g.Bt + (size_t)cur.pn * tstep;
    S.a_ready(cur);
    if constexpr (SP2) {
        PG8_STAGE(PG8_SB(0, 0), cB, voffB); PG8_STAGE(PG8_SB(0, 1), cB + hstep, voffB); PG8_STAGE(PG8_SA(0, 0), cA, voffA); PG8_STAGE(PG8_SA(0, 1), cA + hstep, voffA);
        if (wr == 1) PG8_BAR;
        PG8_WAIT_V(2); PG8_BAR;
        PG8_STAGE(PG8_SB(1, 0), cB + kstep, voffB); PG8_STAGE(PG8_SA(1, 0), cA + kstep, voffA); PG8_STAGE(PG8_SB(1, 1), cB + hstep + kstep, voffB);
        PG8_WAIT_V(6); PG8_BAR;
    } else {
        PG8_STAGE(PG8_SB(0, 0), cB, voffB); PG8_STAGE(PG8_SA(0, 0), cA, voffA); PG8_STAGE(PG8_SB(0, 1), cB + hstep, voffB); PG8_STAGE(PG8_SA(0, 1), cA + hstep, voffA);
        if (wr == 1) PG8_BAR;
        PG8_WAIT_V(4); PG8_BAR;
        PG8_STAGE(PG8_SB(1, 0), cB + kstep, voffB); PG8_STAGE(PG8_SA(1, 0), cA + kstep, voffA); PG8_STAGE(PG8_SB(1, 1), cB + hstep + kstep, voffB);
        PG8_WAIT_V(6); PG8_BAR;
    }
    for (;;) {
        const bool has_next = S.next(ui + 1, nxt);
        const char* nA = has_next ? (const char*)g.A + (size_t)nxt.pm * tstep : cA; const char* nB = has_next ? (const char*)g.Bt + (size_t)nxt.pn * tstep : cB;
        for (int t = 0; t < nt; t += 2) {
            const bool last = (t == nt - 2);
            const char* a1 = cA + (size_t)(t + 1) * kstep;
            const char* a2 = last ? nA : cA + (size_t)(t + 2) * kstep; const char* b2 = last ? nB : cB + (size_t)(t + 2) * kstep;
            const char* a3 = a2 + kstep; const char* b3 = b2 + kstep;
            if (last && has_next) S.a_ready(nxt);
            if constexpr (SP2) {
            PG8_LDB(B0, 0, 0); PG8_LDB(B1, 0, 1); PG8_SCHED; PG8_LDA(At, 0, 0); PG8_STAGE(PG8_SA(1, 1), a1 + hstep, voffA);
            PG8_WAIT_V(8); PG8_WAIT_L(0); PG8_BAR; PG8_MMA(0, 0, At, B0); PG8_MMA(0, 1, At, B1); PG8_BAR; PG8_SCHED;
            PG8_LDA(At, 0, 1); PG8_STAGE(PG8_SB(0, 0), b2, voffB); PG8_STAGE(PG8_SB(0, 1), b2 + hstep, voffB); PG8_STAGE(PG8_SA(0, 0), a2, voffA);
            PG8_WAIT_V(8); PG8_WAIT_L(0); PG8_BAR; PG8_MMA(1, 0, At, B0); PG8_MMA(1, 1, At, B1); PG8_BAR; PG8_SCHED;
            PG8_LDB(B0, 1, 0); PG8_LDB(B1, 1, 1); PG8_SCHED; PG8_LDA(At, 1, 0); PG8_STAGE(PG8_SA(0, 1), a2 + hstep, voffA);
            PG8_WAIT_V(8); PG8_WAIT_L(0); PG8_BAR; PG8_MMA(0, 0, At, B0); PG8_MMA(0, 1, At, B1); PG8_BAR; PG8_SCHED;
            PG8_LDA(At, 1, 1); PG8_STAGE(PG8_SB(1, 0), b3, voffB); PG8_STAGE(PG8_SB(1, 1), b3 + hstep, voffB); PG8_STAGE(PG8_SA(1, 0), a3, voffA);
            PG8_WAIT_V(8); PG8_WAIT_L(0); PG8_BAR; PG8_MMA(1, 0, At, B0); PG8_MMA(1, 1, At, B1); PG8_BAR; PG8_SCHED;
            } else {
            PG8_LDB(B0, 0, 0); PG8_SCHED; PG8_LDA(At, 0, 0); PG8_STAGE(PG8_SA(1, 1), a1 + hstep, voffA);
            PG8_WAIT_L(8); PG8_BAR; PG8_WAIT_L(0); PG8_MMA(0, 0, At, B0); PG8_BAR; PG8_SCHED;
            PG8_LDB(B1, 0, 1); PG8_STAGE(PG8_SB(0, 0), b2, voffB);
            PG8_BAR; PG8_WAIT_L(0); PG8_MMA(0, 1, At, B1); PG8_BAR;
            PG8_LDA(At, 0, 1); PG8_STAGE(PG8_SA(0, 0), a2, voffA);
            PG8_BAR; PG8_WAIT_L(0); PG8_MMA(1, 0, At, B0); PG8_BAR; PG8_SCHED;
            PG8_STAGE(PG8_SB(0, 1), b2 + hstep, voffB);
            PG8_WAIT_V(6); PG8_BAR; PG8_MMA(1, 1, At, B1); PG8_BAR;
            PG8_LDB(B0, 1, 0); PG8_SCHED; PG8_LDA(At, 1, 0); PG8_STAGE(PG8_SA(0, 1), a2 + hstep, voffA);
            PG8_WAIT_L(8); PG8_BAR; PG8_WAIT_L(0); PG8_MMA(0, 0, At, B0); PG8_BAR; PG8_SCHED;
            PG8_LDB(B1, 1, 1); PG8_STAGE(PG8_SB(1, 0), b3, voffB);
            PG8_BAR; PG8_WAIT_L(0); PG8_MMA(0, 1, At, B1); PG8_BAR;
            PG8_LDA(At, 1, 1); PG8_STAGE(PG8_SA(1, 0), a3, voffA);
            PG8_BAR; PG8_WAIT_L(0); PG8_MMA(1, 0, At, B0); PG8_BAR; PG8_SCHED;
            PG8_STAGE(PG8_SB(1, 1), b3 + hstep, voffB);
            PG8_WAIT_V(6); PG8_BAR; PG8_MMA(1, 1, At, B1); PG8_BAR;
            }
        }
        if constexpr (ALIGN_EPI) { if (wr == 0) PG8_BAR; }
        if constexpr (!Epi::AFTER_DRAIN) { E(acc, cur, wr, wc, fr, fq); S.done(cur); }
        if (!has_next) break;
#pragma unroll
        for (int a = 0; a < 2; ++a)
#pragma unroll
            for (int b = 0; b < 2; ++b)
#pragma unroll
                for (int m = 0; m < 4; ++m)
#pragma unroll
                    for (int n = 0; n < 2; ++n) acc[a][b][m][n] = (f32x4){0.f, 0.f, 0.f, 0.f};
        cur = nxt; cA = nA; cB = nB; ++ui;
        if constexpr (ALIGN_EPI) { if (wr == 1) PG8_BAR; }
    }
    PG8_WAIT_V(0);
    if constexpr (!ALIGN_EPI) { if (wr == 0) PG8_BAR; }
    PG8_BAR;
    if constexpr (Epi::AFTER_DRAIN) { E.fused(acc, cur, wr, wc, fr, fq, lds, wid, lane); S.done(cur); }
#undef PG8_SA
#undef PG8_SB
#undef PG8_STAGE
#undef PG8_LDA
#undef PG8_LDB
#undef PG8_MMA
#undef PG8_WAIT_V
#undef PG8_WAIT_L
#undef PG8_BAR
#undef PG8_SCHED
}
}

namespace att {
#define LAS __attribute__((address_space(3)))
typedef short bf16x8 __attribute__((ext_vector_type(8)));
typedef short s16x4 __attribute__((ext_vector_type(4)));
typedef float f32x16 __attribute__((ext_vector_type(16)));
typedef float f32x4 __attribute__((ext_vector_type(4)));
typedef unsigned u32x4 __attribute__((ext_vector_type(4)));
typedef unsigned u32x2 __attribute__((ext_vector_type(2)));
typedef LAS unsigned char lchar;
typedef unsigned short bf16_t;
constexpr int MP = 32768, LDQ = 3072;
constexpr float LOG2E = 1.4426950408889634f;
constexpr float C2 = 0.125f * LOG2E;
constexpr float NEG_BIG = -1e30f;

struct Params {
    const bf16_t* qkv;
    const float *cdk, *cdv, *csk, *csv;
    bf16_t* mixed;
    unsigned* queue;
    float lam;
};

__device__ __forceinline__ int crow(int r, int hi) { return (r & 3) + 8 * (r >> 2) + 4 * hi; }
typedef float f32x2_t __attribute__((ext_vector_type(2))); typedef __bf16 bf16x2_t __attribute__((ext_vector_type(2)));
__device__ __forceinline__ unsigned cvtpk(float lo, float hi) { const f32x2_t v = {lo, hi}; const bf16x2_t b = __builtin_convertvector(v, bf16x2_t); return __builtin_bit_cast(unsigned, b); }
__device__ __forceinline__ u32x4 pack8(f32x4 a, f32x4 b) { u32x4 w; w.x = cvtpk(a[0], a[1]); w.y = cvtpk(a[2], a[3]); w.z = cvtpk(b[0], b[1]); w.w = cvtpk(b[2], b[3]); return w; }
__device__ __forceinline__ bf16x8 vfrag(const lchar* p0, const lchar* p1) {
    const s16x4 a = __builtin_bit_cast(s16x4, __builtin_amdgcn_ds_read_tr16_b64_v4i16((LAS s16x4*)p0));
    const s16x4 b = __builtin_bit_cast(s16x4, __builtin_amdgcn_ds_read_tr16_b64_v4i16((LAS s16x4*)p1));
    return (bf16x8){a[0], a[1], a[2], a[3], b[0], b[1], b[2], b[3]};
}
__device__ __forceinline__ bf16x8 pfrag(const f32x16& p, int s) {
    u32x4 w; w.x = cvtpk(p[8 * s + 0], p[8 * s + 1]); w.y = cvtpk(p[8 * s + 2], p[8 * s + 3]); w.z = cvtpk(p[8 * s + 4], p[8 * s + 5]); w.w = cvtpk(p[8 * s + 6], p[8 * s + 7]);
    return __builtin_bit_cast(bf16x8, w);
}
__device__ __forceinline__ int offKd(int row, int ch) { return row * 256 + ((ch ^ (row & 15)) << 4); }
__device__ __forceinline__ int offVd(int row, int ch) { return row * 256 + ((ch ^ (((row & 3) << 2) | ((row >> 2) & 3))) << 4); }
__device__ __forceinline__ int offKs(int row, int ch) { return row * 128 + ((ch ^ (row & 7)) << 4); }
__device__ __forceinline__ int offVs(int row, int ch) { return row * 128 + ((ch ^ (((row >> 1) & 1) << 2)) << 4); }

constexpr int DBUF = 32768;
constexpr int SBUF = 16384;

__device__ __forceinline__ void diff_sub(const lchar* Kb, const lchar* Vb, int sub, int map, const bf16x8 (&qf)[4], f32x16 (&O)[4],
                                         float& m0, float& l0, float dq, float sl2, int lane, bool left) {
    const int r32 = lane & 31, hi = lane >> 5;
    f32x16 s;
    if (left) { const float base = -sl2 * dq;
#pragma unroll
        for (int r = 0; r < 16; ++r) s[r] = __builtin_fmaf(sl2, (float)((r & 3) + 8 * (r >> 2)), base); }
    else {
#pragma unroll
        for (int r = 0; r < 16; ++r) s[r] = -sl2 * __builtin_fabsf(dq - (float)((r & 3) + 8 * (r >> 2))); }
    const int krow = sub * 32 + r32;
    bf16x8 kf[4];
#pragma unroll
    for (int ds = 0; ds < 4; ++ds) kf[ds] = *(const LAS bf16x8*)(Kb + offKd(krow, 8 * map + 2 * ds + hi));
    const int q4 = (lane & 15) >> 2, p = lane & 3, g1 = (lane >> 4) & 1;
    bf16x8 vf[2][4];
#pragma unroll
    for (int sk = 0; sk < 2; ++sk)
#pragma unroll
        for (int d = 0; d < 4; ++d) {
            const int ch = d * 4 + 2 * g1 + (p >> 1);
            const int ra = sub * 32 + 16 * sk + 4 * hi + q4, rb = ra + 8;
            vf[sk][d] = vfrag(Vb + offVd(ra, ch) + 8 * (p & 1), Vb + offVd(rb, ch) + 8 * (p & 1));
        }
#pragma unroll
    for (int ds = 0; ds < 4; ++ds) s = __builtin_amdgcn_mfma_f32_32x32x16_bf16(kf[ds], qf[ds], s, 0, 0, 0);
    float mx = s[0];
#pragma unroll
    for (int r = 1; r < 16; ++r) mx = __builtin_fmaxf(mx, s[r]);
    mx = __builtin_fmaxf(mx, __shfl_xor(mx, 32));
    const float n0 = __builtin_fmaxf(m0, mx);
    if (__any(n0 > m0 + 24.f)) {
        const float f0 = __builtin_amdgcn_exp2f(__builtin_fmaxf(m0 - n0, -200.f));
        l0 *= f0;
#pragma unroll
        for (int d = 0; d < 4; ++d)
#pragma unroll
            for (int r = 0; r < 16; ++r) O[d][r] *= f0;
        m0 = n0;
    }
    float a0 = 0.f;
#pragma unroll
    for (int r = 0; r < 16; ++r) { s[r] = __builtin_amdgcn_exp2f(__builtin_fmaxf(s[r] - m0, -200.f)); a0 += s[r]; }
    l0 += a0;
    bf16x8 p0[2];
    p0[0] = pfrag(s, 0); p0[1] = pfrag(s, 1);
#pragma unroll
    for (int sk = 0; sk < 2; ++sk)
#pragma unroll
        for (int d = 0; d < 4; ++d) O[d] = __builtin_amdgcn_mfma_f32_32x32x16_bf16(vf[sk][d], p0[sk], O[d], 0, 0, 0);
}

__device__ __forceinline__ u32x4 ld_f32x8_bf16(const float* p) { const f32x4 a = *(const f32x4*)p, b = *(const f32x4*)(p + 4); return pack8(a, b); }

template <bool SAMPLE>
__device__ __forceinline__ void diff_unit(lchar* lds, const Params& P, const LAS float* gt, int b, int h, int qb) {
    int tid_ = threadIdx.x; asm volatile("" : "+v"(tid_));
    const int tid = tid_, lane = tid & 63, wid = __builtin_amdgcn_readfirstlane(tid >> 6), r32 = lane & 31, hi = lane >> 5;
    const int map = wid & 1, qg = SAMPLE ? ((wid >> 1) & 1) : (wid >> 1);
    const int q0 = SAMPLE ? 0 : qb * 128;
    const size_t qrow_g = SAMPLE ? (size_t)MP + b * 64 + qg * 32 + r32 : (size_t)b * 2048 + q0 + qg * 32 + r32;
    const int qpos = SAMPLE ? 4096 + qg * 32 + r32 : q0 + qg * 32 + r32;
    const int ntiles = SAMPLE ? 65 : 2 * qb + 2;
    const int tw = SAMPLE ? 64 : (q0 + qg * 32) >> 6;
    const bool compute_wave = true;
    const bool epi_wave = SAMPLE ? (wid < 4) : true;
    const int ksub = wid >> 2;
    const float sl2 = __builtin_amdgcn_exp2f(-2.0f * (float)(h + 1)) * LOG2E;
    bf16x8 qf[4];
#pragma unroll
    for (int ds = 0; ds < 4; ++ds) qf[ds] = *(const bf16x8*)(P.qkv + qrow_g * LDQ + h * 128 + map * 64 + ds * 16 + hi * 8);
    f32x16 O[4];
#pragma unroll
    for (int d = 0; d < 4; ++d) O[d] = (f32x16){};
    float m0 = NEG_BIG, l0 = 0.f;

    auto kvbf = [&](int which, int t, int row, int ch) -> const bf16_t* {
        const size_t r = SAMPLE ? (size_t)MP + b * 64 + row : (size_t)b * 2048 + t * 64 + row;
        return P.qkv + r * LDQ + (which ? 1024 : 512) + h * 128 + ch * 8; };
    auto kvf32 = [&](int which, int t, int row, int ch) -> const float* { return (which ? P.cdv : P.cdk) + ((size_t)b * 4096 + t * 64 + row) * 512 + h * 128 + ch * 8; };
    {
        u32x4 rk[2], rv[2]; f32x4 fk[SAMPLE ? 4 : 1], fv[SAMPLE ? 4 : 1];
        auto tile_load = [&](int t) {
#pragma unroll
            for (int i = 0; i < 2; ++i) { const int idx = tid + 512 * i, row = idx >> 4, ch = idx & 15;
                if (SAMPLE && t < 64) { const float* pk = kvf32(0, t, row, ch); const float* pv = kvf32(1, t, row, ch);
                    fk[(2 * i) % (SAMPLE ? 4 : 1)] = __builtin_nontemporal_load((const f32x4*)pk); fk[(2 * i + 1) % (SAMPLE ? 4 : 1)] = __builtin_nontemporal_load((const f32x4*)(pk + 4)); fv[(2 * i) % (SAMPLE ? 4 : 1)] = __builtin_nontemporal_load((const f32x4*)pv); fv[(2 * i + 1) % (SAMPLE ? 4 : 1)] = __builtin_nontemporal_load((const f32x4*)(pv + 4)); }
                else { rk[i] = *(const u32x4*)kvbf(0, t, row, ch); rv[i] = *(const u32x4*)kvbf(1, t, row, ch); } } };
        auto tile_store = [&](int t, lchar* buf) {
#pragma unroll
            for (int i = 0; i < 2; ++i) { const int idx = tid + 512 * i, row = idx >> 4, ch = idx & 15;
                if (SAMPLE && t < 64) { rk[i] = pack8(fk[(2 * i) % (SAMPLE ? 4 : 1)], fk[(2 * i + 1) % (SAMPLE ? 4 : 1)]); rv[i] = pack8(fv[(2 * i) % (SAMPLE ? 4 : 1)], fv[(2 * i + 1) % (SAMPLE ? 4 : 1)]); }
                *(LAS u32x4*)(buf + offKd(row, ch)) = rk[i]; *(LAS u32x4*)(buf + 16384 + offVd(row, ch)) = rv[i]; } };
        tile_load(0); tile_store(0, lds);
        __syncthreads();
        for (int t = 0; t < ntiles; ++t) {
            const lchar* cur = lds + (t & 1) * DBUF; lchar* nxt = lds + ((t + 1) & 1) * DBUF;
            const bool more = (t + 1 < ntiles);
            if (more) tile_load(t + 1);
            if (SAMPLE) diff_sub(cur, cur + 16384, ksub, map, qf, O, m0, l0, (float)(qpos - t * 64 - ksub * 32 - 4 * hi), sl2, lane, (t < 64) || (ksub < qg));
            else if (t <= tw) {
#pragma unroll
                for (int sub = 0; sub < 2; ++sub) diff_sub(cur, cur + 16384, sub, map, qf, O, m0, l0, (float)(qpos - t * 64 - sub * 32 - 4 * hi), sl2, lane, (t * 64 + sub * 32 + 31) < (q0 + qg * 32));
            }
            if (more) tile_store(t + 1, nxt);
            __syncthreads();
        }
    }
    if (SAMPLE) {
        LAS float* cb2 = (LAS float*)lds + (wid & 3) * 4224 + lane;
        if (wid >= 4) { cb2[0] = m0; cb2[64] = l0;
#pragma unroll
            for (int d = 0; d < 4; ++d)
#pragma unroll
                for (int r = 0; r < 16; ++r) cb2[(2 + d * 16 + r) * 64] = O[d][r]; }
        __syncthreads();
        if (wid < 4) { const float mP = cb2[0], lP = cb2[64], mm = __builtin_fmaxf(m0, mP);
            const float f = __builtin_amdgcn_exp2f(__builtin_fmaxf(m0 - mm, -200.f)), fP = __builtin_amdgcn_exp2f(__builtin_fmaxf(mP - mm, -200.f));
            l0 = l0 * f + lP * fP; m0 = mm;
#pragma unroll
            for (int d = 0; d < 4; ++d)
#pragma unroll
                for (int r = 0; r < 16; ++r) O[d][r] = O[d][r] * f + cb2[(2 + d * 16 + r) * 64] * fP; }
        __syncthreads();
    }
    l0 += __shfl_xor(l0, 32);
    LAS float* xb = (LAS float*)lds + qg * 4096 + lane;
    if (epi_wave && map == 1) {
        const float i1 = P.lam / l0;
#pragma unroll
        for (int d = 0; d < 4; ++d)
#pragma unroll
            for (int r = 0; r < 16; ++r) xb[(d * 16 + r) * 64] = O[d][r] * i1;
    }
    __syncthreads();
    if (epi_wave && map == 0) {
        const float i0 = 1.0f / l0;
        float ss = 0.f;
#pragma unroll
        for (int d = 0; d < 4; ++d)
#pragma unroll
            for (int r = 0; r < 16; ++r) { const float o = O[d][r] * i0 - xb[(d * 16 + r) * 64]; O[d][r] = o; ss += o * o; }
        ss += __shfl_xor(ss, 32);
        const float rs = __builtin_amdgcn_rsqf(ss * (1.0f / 128.0f) + 1e-6f) * 0.8f;
        bf16_t* orow = P.mixed + qrow_g * 1024 + h * 128;
#pragma unroll
        for (int d = 0; d < 4; ++d)
#pragma unroll
            for (int G = 0; G < 4; ++G) {
                const int d0 = d * 32 + 8 * G + 4 * hi;
                u32x2 w; w.x = cvtpk(O[d][4 * G + 0] * rs * gt[d0 + 0], O[d][4 * G + 1] * rs * gt[d0 + 1]); w.y = cvtpk(O[d][4 * G + 2] * rs * gt[d0 + 2], O[d][4 * G + 3] * rs * gt[d0 + 3]);
                *(u32x2*)(orow + d0) = w;
            }
    }
}

__device__ __forceinline__ void sb_sub(const lchar* Kb, const lchar* Vb, int sub, bool diag, const bf16x8 (&qf)[4], f32x16 (&O)[2], float& R, int lane) {
    const int r32 = lane & 31, hi = lane >> 5;
    f32x16 z = {};
    const int krow = sub * 32 + r32;
    bf16x8 kf[4];
#pragma unroll
    for (int ds = 0; ds < 4; ++ds) kf[ds] = *(const LAS bf16x8*)(Kb + offKs(krow, 2 * ds + hi));
    const int q4 = (lane & 15) >> 2, p = lane & 3, g1 = (lane >> 4) & 1;
    bf16x8 vf[2][2];
#pragma unroll
    for (int s = 0; s < 2; ++s)
#pragma unroll
        for (int d = 0; d < 2; ++d) {
            const int ch = d * 4 + 2 * g1 + (p >> 1);
            const int ra = sub * 32 + 16 * s + 4 * hi + q4, rb = ra + 8;
            vf[s][d] = vfrag(Vb + offVs(ra, ch) + 8 * (p & 1), Vb + offVs(rb, ch) + 8 * (p & 1));
        }
#pragma unroll
    for (int ds = 0; ds < 4; ++ds) z = __builtin_amdgcn_mfma_f32_32x32x16_bf16(kf[ds], qf[ds], z, 0, 0, 0);
    f32x16 lk;
#pragma unroll
    for (int r = 0; r < 16; ++r) {
        const float zc = __builtin_amdgcn_fmed3f(z[r], -200.f, 80.f);
        float l = -__builtin_amdgcn_logf(1.0f + __builtin_amdgcn_exp2f(zc));
        float ls = zc + l;
        if (diag && !(crow(r, hi) < r32)) { l = 0.f; ls = NEG_BIG; }
        lk[r] = l; z[r] = ls;
    }
    float run = R;
#pragma unroll
    for (int G = 3; G >= 0; --G) {
        const float T = (lk[4 * G] + lk[4 * G + 1]) + (lk[4 * G + 2] + lk[4 * G + 3]);
        const float To = __shfl_xor(T, 32);
        const float a3 = run + (hi == 0 ? To : 0.f);
        const float a2 = a3 + lk[4 * G + 3], a1 = a2 + lk[4 * G + 2], a0 = a1 + lk[4 * G + 1];
        z[4 * G + 3] = __builtin_amdgcn_exp2f(__builtin_fmaxf(z[4 * G + 3] + a3, -200.f)); z[4 * G + 2] = __builtin_amdgcn_exp2f(__builtin_fmaxf(z[4 * G + 2] + a2, -200.f));
        z[4 * G + 1] = __builtin_amdgcn_exp2f(__builtin_fmaxf(z[4 * G + 1] + a1, -200.f)); z[4 * G + 0] = __builtin_amdgcn_exp2f(__builtin_fmaxf(z[4 * G + 0] + a0, -200.f));
        run += T + To;
    }
    R = run;
    bf16x8 pf[2]; pf[0] = pfrag(z, 0); pf[1] = pfrag(z, 1);
#pragma unroll
    for (int s = 0; s < 2; ++s)
#pragma unroll
        for (int d = 0; d < 2; ++d) O[d] = __builtin_amdgcn_mfma_f32_32x32x16_bf16(vf[s][d], pf[s], O[d], 0, 0, 0);
}

__device__ __forceinline__ void sb_unit(const bool SAMPLE, lchar* lds, const Params& P, int b, int h, int qb) {
    int tid_ = threadIdx.x; asm volatile("" : "+v"(tid_));
    const int tid = tid_, lane = tid & 63, wid = __builtin_amdgcn_readfirstlane(tid >> 6), r32 = lane & 31, hi = lane >> 5;
    const int q0 = SAMPLE ? 4096 : qb * 256;
    const int wq0 = q0 + (SAMPLE ? (wid & 1) : wid) * 32;
    const size_t qrow_g = SAMPLE ? (size_t)MP + b * 64 + (wid & 1) * 32 + r32 : (size_t)b * 2048 + wq0 + r32;
    const int thi = SAMPLE ? 64 : 4 * qb + 3;
    const int tw = wq0 >> 6, sw = (wq0 >> 5) & 1;
    const bool compute_wave = SAMPLE ? (wid < 2) : true;
    bf16x8 qf[4];
#pragma unroll
    for (int ds = 0; ds < 4; ++ds) qf[ds] = *(const bf16x8*)(P.qkv + qrow_g * LDQ + 1536 + h * 64 + ds * 16 + hi * 8);
    f32x16 O[2]; O[0] = (f32x16){}; O[1] = (f32x16){};
    float R = 0.f;
    auto compute = [&](int t, const lchar* cur) {
        if (t > tw) return;
        if (__all(R < -160.f)) return;
        if (t == tw) {
            if (sw == 1) { sb_sub(cur, cur + 8192, 1, true, qf, O, R, lane); sb_sub(cur, cur + 8192, 0, false, qf, O, R, lane); }
            else sb_sub(cur, cur + 8192, 0, true, qf, O, R, lane);
        } else { sb_sub(cur, cur + 8192, 1, false, qf, O, R, lane); sb_sub(cur, cur + 8192, 0, false, qf, O, R, lane); }
    };
    auto kvload = [&](int which, int t, int row, int ch) -> u32x4 {
        if (SAMPLE && t < 64) return ld_f32x8_bf16((which ? P.csv : P.csk) + ((size_t)b * 4096 + t * 64 + row) * 512 + h * 64 + ch * 8);
        const size_t r = SAMPLE ? (size_t)MP + b * 64 + row : (size_t)b * 2048 + t * 64 + row;
        return *(const u32x4*)(P.qkv + r * LDQ + (which ? 2560 : 2048) + h * 64 + ch * 8); };
    {
        const int row = tid >> 3, ch = tid & 7;
        u32x4 rk = kvload(0, thi, row, ch), rv = kvload(1, thi, row, ch);
        *(LAS u32x4*)(lds + offKs(row, ch)) = rk; *(LAS u32x4*)(lds + 8192 + offVs(row, ch)) = rv;
        __syncthreads();
        int par = 0;
        volatile LAS int* dflag = (volatile LAS int*)(lds + 131072 + 1600);
        for (int t = thi; t >= 0; --t, par ^= 1) {
            const lchar* cur = lds + par * SBUF; lchar* nxt = lds + (par ^ 1) * SBUF;
            if (t > 0) { rk = kvload(0, t - 1, row, ch); rv = kvload(1, t - 1, row, ch); }
            if (compute_wave) compute(t, cur);
            if (t > 0) { *(LAS u32x4*)(nxt + offKs(row, ch)) = rk; *(LAS u32x4*)(nxt + 8192 + offVs(row, ch)) = rv; }
            const int wdone = (!compute_wave || (t <= tw && __all(R < -160.f))) ? 1 : 0;
            if (lane == 0) dflag[par * 8 + wid] = wdone;
            __syncthreads();
            int alld = 1;
#pragma unroll
            for (int w = 0; w < 8; ++w) alld &= dflag[par * 8 + w];
            if (alld) break;
        }
    }
    if (compute_wave) {
        bf16_t* orow = P.mixed + qrow_g * 1024 + 512 + h * 64;
#pragma unroll
        for (int d = 0; d < 2; ++d)
#pragma unroll
            for (int G = 0; G < 4; ++G) {
                const int d0 = d * 32 + 8 * G + 4 * hi;
                u32x2 w; w.x = cvtpk(O[d][4 * G + 0], O[d][4 * G + 1]); w.y = cvtpk(O[d][4 * G + 2], O[d][4 * G + 3]);
                *(u32x2*)(orow + d0) = w;
            }
    }
}

constexpr int N_UNITS = 192 + 8 * 256;
__device__ __forceinline__ void attn_phase(lchar* lds, Params P, const float* subln_g, int u_base, int u_end) {
    LAS float* gt = (LAS float*)(lds + 131072 + 1024);
    volatile LAS int* slot = (volatile LAS int*)(lds + 131072 + 1536);
    if (threadIdx.x < 128) gt[threadIdx.x] = subln_g[threadIdx.x];
    __syncthreads();
    for (;;) {
        if (threadIdx.x == 0) *slot = u_base + (int)atomicAdd(P.queue, 1u);
        __syncthreads();
        const int u = __builtin_amdgcn_readfirstlane(*slot);
        __syncthreads();
        if (u >= u_end) break;
        if (u < 64) { diff_unit<true>(lds, P, gt, u >> 2, u & 3, 0); }
        else if (u < 192) { const int j = u - 64; sb_unit(true, lds, P, j >> 3, j & 7, 0); }
        else {
            const int j = u - 192, g = 7 - (j >> 8), k = j & 255;
            if (k < 128) { diff_unit<false>(lds, P, gt, (k & 63) >> 2, k & 3, 2 * g + 1 - (k >> 6)); }
            else { const int kk = k - 128; sb_unit(false, lds, P, kk >> 3, kk & 7, g); }
        }
    }
}
#undef LAS
}

#define GAS __attribute__((address_space(1)))
#define LAS __attribute__((address_space(3)))
typedef unsigned short bf16;
typedef unsigned v4u __attribute__((ext_vector_type(4)));
typedef float f32x4 __attribute__((ext_vector_type(4)));
constexpr int NWAVES = 8;
constexpr int MT = 33792, MP = 32768, DM = 1024, NIN = 3072, FF = 2816;
constexpr size_t MiB = 1u << 20;
constexpr size_t WS_CTL = 0;
constexpr size_t WS_WIN = 1 * MiB;
constexpr size_t WS_WOUT = 7 * MiB;
constexpr size_t WS_WGU = 9 * MiB;
constexpr size_t WS_WDN = 20 * MiB;
constexpr size_t WS_SSQ1 = 26 * MiB;
constexpr size_t WS_SSQ2 = 29 * MiB;
constexpr size_t WS_XN = 32 * MiB;
constexpr size_t WS_HB = 100 * MiB;
constexpr size_t WS_QKV = 168 * MiB;
constexpr size_t WS_CACHE = 368 * MiB;
constexpr size_t WS_END = 624 * MiB;
constexpr int RING_BYTES = 131072, LDS_BYTES = 147456;

__device__ __forceinline__ unsigned f2bf(float f) { unsigned u = __builtin_bit_cast(unsigned, f); return (u + 0x7fffu + ((u >> 16) & 1u)) >> 16; }
__device__ __forceinline__ unsigned pk2(float lo, float hi) { return f2bf(lo) | (f2bf(hi) << 16); }
__device__ __forceinline__ float wave_sum(float v) {
#pragma unroll
    for (int o = 1; o < 64; o <<= 1) v += __shfl_xor(v, o);
    return v;
}
__device__ __forceinline__ void transpose_item(const float* W, int K, int N, bf16* WT, int k0, int n0, int orow0, const float* kscale, LAS float* scr, int lane) {
#pragma unroll 8
    for (int i = 0; i < 32; ++i) { const int kk = 2 * i + (lane >> 5); float v = W[(size_t)(k0 + kk) * N + n0 + (lane & 31)]; if (kscale) v *= kscale[k0 + kk]; scr[kk * 33 + (lane & 31)] = v; }
    asm volatile("s_waitcnt lgkmcnt(0)" ::: "memory");
    const int c = lane & 7;
#pragma unroll
    for (int j = 0; j < 4; ++j) { const int n = (lane >> 3) + 8 * j; const LAS float* s = scr + (8 * c) * 33 + n;
        v4u o; o.x = pk2(s[0 * 33], s[1 * 33]); o.y = pk2(s[2 * 33], s[3 * 33]); o.z = pk2(s[4 * 33], s[5 * 33]); o.w = pk2(s[6 * 33], s[7 * 33]);
        *(v4u*)(WT + (size_t)(orow0 + n) * K + k0 + 8 * c) = o; }
    asm volatile("s_waitcnt lgkmcnt(0)" ::: "memory");
}

#define XB_TMO      128
#define XB_XCNT(j)  (256  + 64 * (j))
#define XB_XSUB(j)  (1280 + 64 * (j))
#define XB_XGEN(j)  (2304 + 64 * (j))
#define XB_TOP      3328
#define XB_TOPGEN   3392
#define XCD_BAR_WORDS 3456
#define XB_SPIN_CAP (1u << 18)

__device__ __forceinline__ unsigned xb_ld(unsigned* p)              { return __hip_atomic_load(p, __ATOMIC_RELAXED, __HIP_MEMORY_SCOPE_AGENT); }
__device__ __forceinline__ unsigned xb_add(unsigned* p, unsigned v) { return __hip_atomic_fetch_add(p, v, __ATOMIC_RELAXED, __HIP_MEMORY_SCOPE_AGENT); }
__device__ __forceinline__ unsigned xb_xcc_id() { return (unsigned)__builtin_amdgcn_s_getreg((3 << 11) | 20) & 0xFu; }
#define XB_SPIN(cond, bar) do { unsigned _sp = 0; while (cond) { __builtin_amdgcn_s_sleep(1); \
    if ((++_sp & 255u) == 0u) { if (xb_ld(&(bar)[XB_TMO])) break; if (_sp > XB_SPIN_CAP) { atomicAdd(&(bar)[XB_TMO], 1u); break; } } } } while (0)

struct XcdBarrier {
    unsigned* bar; unsigned x;
    volatile LAS unsigned* st;
};

__device__ __forceinline__ XcdBarrier xcd_barrier_post(unsigned* bar, volatile LAS unsigned* st) {
    XcdBarrier b; b.bar = bar; b.x = xb_xcc_id(); b.st = st;
    if (threadIdx.x == 0) (void)xb_add(&bar[XB_XCNT(b.x)], 1u);
    return b;
}
__device__ __forceinline__ void xcd_barrier_complete(unsigned* bar, unsigned x, unsigned& nloc, unsigned& nx) {
    const unsigned G = gridDim.x * gridDim.y * gridDim.z;
    unsigned sum, cnt, mine, sp = 0u;
    for (;;) {
        sum = 0u; cnt = 0u; mine = 0u;
#pragma unroll
        for (unsigned j = 0; j < 16; ++j) { const unsigned c = xb_ld(&bar[XB_XCNT(j)]); sum += c; cnt += (c > 0u) ? 1u : 0u; mine = (j == x) ? c : mine; }
        if (sum == G) break;
        __builtin_amdgcn_s_sleep(1);
        if ((++sp & 255u) == 0u) { if (xb_ld(&bar[XB_TMO])) break; if (sp > XB_SPIN_CAP) { atomicAdd(&bar[XB_TMO], 1u); break; } }
    }
    nloc = mine > 0u ? mine : 1u; nx = cnt > 0u ? cnt : 1u;
}

__device__ __forceinline__ void xcd_barrier(const XcdBarrier& b) {
    asm volatile("s_waitcnt vmcnt(0)" ::: "memory");
    __syncthreads();
    if (threadIdx.x == 0) {
        unsigned* bar = b.bar;
        __builtin_amdgcn_s_waitcnt(0);
        unsigned nloc = b.st[0], nx = b.st[1];
        if (nloc == 0u) { xcd_barrier_complete(bar, b.x, nloc, nx); b.st[0] = nloc; b.st[1] = nx; }
        const unsigned old = xb_add(&bar[XB_XSUB(b.x)], 1u);
        const unsigned gen = old / nloc;
        if (old + 1u == (gen + 1u) * nloc) {
            __builtin_amdgcn_fence(__ATOMIC_RELEASE, "agent");
            asm volatile("s_waitcnt vmcnt(0)" ::: "memory");
            const unsigned og = xb_add(&bar[XB_TOP], 1u);
            const unsigned tg = og / nx;
            if (og + 1u == (tg + 1u) * nx) xb_add(&bar[XB_TOPGEN], 1u);
            else XB_SPIN(xb_ld(&bar[XB_TOPGEN]) == tg, bar);
            __builtin_amdgcn_fence(__ATOMIC_ACQUIRE, "agent");
            xb_add(&bar[XB_XGEN(b.x)], 1u);
            asm volatile("s_waitcnt vmcnt(0)" ::: "memory");
        } else {
            XB_SPIN(xb_ld(&bar[XB_XGEN(b.x)]) == gen, bar);
            __builtin_amdgcn_fence(__ATOMIC_ACQUIRE, "agent");
            asm volatile("s_waitcnt vmcnt(0)" ::: "memory");
        }
    }
    __syncthreads();
}


struct Args {
    const float* in[19]; float* out; unsigned char* ws; int ph_lo, ph_hi; int isz[20];
};

__global__ void __launch_bounds__(NWAVES * 64, 2) fwd_kernel(Args args) {
    extern __shared__ __attribute__((aligned(16))) unsigned char lds_raw[];
    LAS unsigned char* lds = (LAS unsigned char*)lds_raw;
    const int tid = threadIdx.x, lane = tid & 63, wave = __builtin_amdgcn_readfirstlane(tid >> 6);
    const int G = gridDim.x;
    unsigned char* ws = args.ws;
    const float* xp = args.in[0]; const float* xs = args.in[1];
    float* out = args.out;
    bf16* Win_t = (bf16*)(ws + WS_WIN); bf16* Wout_t = (bf16*)(ws + WS_WOUT); bf16* Wgu_t = (bf16*)(ws + WS_WGU); bf16* Wdn_t = (bf16*)(ws + WS_WDN);
    bf16* XN = (bf16*)(ws + WS_XN); bf16* HB = (bf16*)(ws + WS_HB); bf16* QKV = (bf16*)(ws + WS_QKV); bf16* ACT = (bf16*)(ws + WS_QKV);
    float* SSQ1 = (float*)(ws + WS_SSQ1); float* SSQ2 = (float*)(ws + WS_SSQ2);
    const int lo = args.ph_lo, hi = args.ph_hi;
#define IN(k) (lo <= (k) && (k) < hi)
    unsigned* barw = (unsigned*)(ws + WS_CTL) + 1024;
    volatile LAS unsigned* MISC = (volatile LAS unsigned*)(lds + 131072 + 320);
    if (tid == 0) { MISC[8] = 0u; MISC[9] = 0u; }
    __syncthreads();
    XcdBarrier xbar = xcd_barrier_post(barw, MISC + 8);
    if (args.ph_lo == 0x7fffffff) cg::this_grid().sync();
#define SEAM(k) do { if (IN(k) && IN((k) + 1)) { xcd_barrier(xbar); } } while (0)

    if (IN(0)) {
        if (blockIdx.x == 0 && tid == 0) { __hip_atomic_store((unsigned*)(ws + WS_CTL), 0u, __ATOMIC_RELAXED, __HIP_MEMORY_SCOPE_AGENT); __hip_atomic_store((unsigned*)(ws + WS_CTL) + 64, 0u, __ATOMIC_RELAXED, __HIP_MEMORY_SCOPE_AGENT); }
        LAS float* scr = (LAS float*)(lds + wave * 16384);
        const int gw = blockIdx.x * NWAVES + wave, NGW = G * NWAVES;
        constexpr int I_IN = 16 * 96, I_OUT = 16 * 32, I_G = 16 * 88, I_D = 44 * 32;
        constexpr int NITEMS = I_IN + I_OUT + 2 * I_G + I_D;
        const float* w_in = args.in[7]; const float* w_out = args.in[13]; const float* g_ffn = args.in[14];
        const float* w_gate = args.in[15]; const float* w_up = args.in[16]; const float* w_down = args.in[17];
        for (int it = gw; it < NITEMS; it += NGW) {
            int r = it;
            if (r < I_IN) { const int kb = r / 96, nb = r % 96; transpose_item(w_in, DM, NIN, Win_t, 64 * kb, 32 * nb, 32 * nb, nullptr, scr, lane); continue; } r -= I_IN;
            if (r < I_OUT) { const int kb = r / 32, nb = r % 32; transpose_item(w_out, DM, DM, Wout_t, 64 * kb, 32 * nb, 32 * nb, nullptr, scr, lane); continue; } r -= I_OUT;
            if (r < I_G) { const int kb = r / 88, nb = r % 88, n0 = 32 * nb; transpose_item(w_gate, DM, FF, Wgu_t, 64 * kb, n0, 256 * (n0 >> 7) + (n0 & 127), g_ffn, scr, lane); continue; } r -= I_G;
            if (r < I_G) { const int kb = r / 88, nb = r % 88, n0 = 32 * nb; transpose_item(w_up, DM, FF, Wgu_t, 64 * kb, n0, 256 * (n0 >> 7) + 128 + (n0 & 127), g_ffn, scr, lane); continue; } r -= I_G;
            { const int kb = r / 32, nb = r % 32; transpose_item(w_down, FF, DM, Wdn_t, 64 * kb, 32 * nb, 32 * nb, nullptr, scr, lane); }
        }
        const float* g_attn = args.in[6];
        f32x4 gv[4];
#pragma unroll
        for (int j = 0; j < 4; ++j) gv[j] = ((const f32x4*)g_attn)[lane + 64 * j];
        for (int m = gw; m < MT; m += NGW) {
            const float* xrow = (m < MP) ? xp + (size_t)m * DM : xs + (size_t)(m - MP) * DM;
            const f32x4* xr = (const f32x4*)xrow + lane;
            f32x4 v[4]; float s = 0.f;
#pragma unroll
            for (int j = 0; j < 4; ++j) { v[j] = xr[64 * j]; s += (v[j].x * v[j].x + v[j].y * v[j].y) + (v[j].z * v[j].z + v[j].w * v[j].w); }
            const float rstd = __builtin_amdgcn_rsqf(wave_sum(s) * (1.f / DM) + 1e-6f);
            unsigned long long* o8 = (unsigned long long*)(XN + (size_t)m * DM) + lane;
#pragma unroll
            for (int j = 0; j < 4; ++j) { const f32x4 w = v[j] * rstd * gv[j]; o8[64 * j] = (unsigned long long)pk2(w.x, w.y) | ((unsigned long long)pk2(w.z, w.w) << 32); }
        }
    }
    SEAM(0);

    if (IN(1)) {
        pg8::Gemm g{XN, Win_t, MT, NIN, DM}; pg8::StaticOrder S; S.init(MT, NIN, G, (int)blockIdx.x);
        pg8::EpiQKV E{QKV, out, att::C2};
        pg8::gemm_phase<pg8::EpiQKV, pg8::StaticOrder, true, true>(lds, g, S, E);
    }
    SEAM(1);

    if (IN(2)) {
        const float d1 = wave_sum(args.in[8][lane] * args.in[9][lane]), d2 = wave_sum(args.in[10][lane] * args.in[11][lane]);
        att::Params P;
        P.qkv = QKV; P.cdk = args.in[2]; P.cdv = args.in[3]; P.csk = args.in[4]; P.csv = args.in[5]; P.mixed = XN; P.queue = (unsigned*)(ws + WS_CTL);
        P.lam = __expf(d1) - __expf(d2) + 0.2f;
        att::attn_phase(lds, P, args.in[12], 0, att::N_UNITS);
    }
    SEAM(2);

    if (IN(3)) {
        pg8::Gemm g{XN, Wout_t, MT, DM, DM};
        pg8::StaticOrder S; S.init(MT, DM, G, (int)blockIdx.x);
        pg8::EpiRes E{xp, xs, out, HB, SSQ1};
        pg8::gemm_phase<pg8::EpiRes, pg8::StaticOrder, true, true>(lds, g, S, E);
    }
    SEAM(3);

    if (IN(4)) {
        pg8::Gemm g{HB, Wgu_t, MT, 2 * FF, DM}; pg8::StaticOrder S; S.init(MT, 2 * FF, G, (int)blockIdx.x);
        pg8::EpiSwiGLU E{ACT, SSQ1};
        pg8::gemm_phase<pg8::EpiSwiGLU, pg8::StaticOrder, true, true>(lds, g, S, E);
    }
    SEAM(4);

    if (IN(5)) {
        pg8::Gemm g{ACT, Wdn_t, MT, DM, FF}; pg8::StaticOrder S; S.init(MT, DM, G, (int)blockIdx.x);
        pg8::EpiRes E{out, out + (size_t)MP * DM, out, nullptr, SSQ2};
        pg8::gemm_phase<pg8::EpiRes, pg8::StaticOrder, true, true>(lds, g, S, E);
    }
    SEAM(5);

    if (IN(6)) {
        const int gw = blockIdx.x * NWAVES + wave, NGW = G * NWAVES;
        const float* g_fin = args.in[18];
        f32x4 gv[4];
#pragma unroll
        for (int j = 0; j < 4; ++j) gv[j] = ((const f32x4*)g_fin)[lane + 64 * j];
        for (int m = gw; m < MT; m += NGW) {
            const float pss = (lane < 16) ? SSQ2[((size_t)(lane >> 2) * MT + m) * 4 + (lane & 3)] : 0.f;
            const float rstd = __builtin_amdgcn_rsqf(wave_sum(pss) * (1.f / DM) + 1e-6f);
            f32x4* yr = (f32x4*)(out + (size_t)m * DM) + lane;
#pragma unroll
            for (int j = 0; j < 4; ++j) { const f32x4 o = __builtin_nontemporal_load(&yr[64 * j]) * rstd * gv[j]; __builtin_nontemporal_store(o, &yr[64 * j]); }
        }
    }
#undef IN
#undef SEAM
}

#ifndef MK_N_LAUNCHES
#define MK_N_LAUNCHES 1
#endif
extern "C" void kernel_launch(void* const* d_in, const int* in_sizes, int n_in, void* d_out, int out_size, void* d_ws, size_t ws_size, hipStream_t stream) {
    static int grid = 0;
    if (grid == 0) {
        if (n_in != 19 || ws_size < WS_END) { fprintf(stderr, "kernel_launch: unexpected n_in %d or ws_size %zu\n", n_in, ws_size); grid = -1; return; }
        int dev = 0, cus = 0, per_cu = 0;
        hipGetDevice(&dev); hipDeviceGetAttribute(&cus, hipDeviceAttributeMultiprocessorCount, dev);
        hipFuncSetAttribute((const void*)fwd_kernel, hipFuncAttributeMaxDynamicSharedMemorySize, LDS_BYTES);
        hipOccupancyMaxActiveBlocksPerMultiprocessor(&per_cu, (const void*)fwd_kernel, NWAVES * 64, LDS_BYTES);
        if (per_cu < 1) { fprintf(stderr, "kernel_launch: occupancy query says %d blocks per CU\n", per_cu); per_cu = 1; }
        (void)hipGetLastError();
        grid = cus * per_cu;
    }
    if (grid < 0) return;
    (void)hipMemsetAsync((char*)d_ws + WS_CTL, 0, 32768, stream);
    Args a{};
    for (int i = 0; i < 19; ++i) a.in[i] = (const float*)d_in[i];
    a.out = (float*)d_out; a.ws = (unsigned char*)d_ws; for (int i = 0; i < 19; ++i) a.isz[i] = in_sizes[i];
    if (MK_N_LAUNCHES == 1) {
        a.ph_lo = 0; a.ph_hi = 7;
        void* kargs[] = {&a};
        hipError_t e = hipLaunchCooperativeKernel((const void*)fwd_kernel, dim3(grid), dim3(NWAVES * 64), kargs, LDS_BYTES, stream);
        if (e != hipSuccess) fprintf(stderr, "cooperative launch failed: %s (grid %d)\n", hipGetErrorString(e), grid);
    } else {
        for (int ph = 0; ph < 7; ++ph) { a.ph_lo = ph; a.ph_hi = ph + 1; hipLaunchKernelGGL(fwd_kernel, dim3(grid), dim3(NWAVES * 64), LDS_BYTES, stream, a); }
    }
}
```

```cpp
#include <hip/hip_runtime.h>
#include <hip/hip_cooperative_groups.h>
#include <cstdio>
#include <cstdint>
namespace cg = cooperative_groups;
namespace pg8 {
#define PG8_LAS __attribute__((address_space(3)))
typedef unsigned short bf16_t;
typedef short bf16x8 __attribute__((ext_vector_type(8)));
typedef float f32x4 __attribute__((ext_vector_type(4)));
typedef unsigned u32x4 __attribute__((ext_vector_type(4)));
constexpr int BM = 256, BK = 64, HALF = 128, HTB = HALF * BK * 2  , STAGE_BYTES = 8 * HTB, NXCD = 8, WGM = 8;

__host__ __device__ __forceinline__ int lds_byte(int r, int c) { const int st = (r >> 4) * 2 + (c >> 5), rr = r & 15, cc = c & 31, ob = rr * 64 + cc * 2; return st * 1024 + (ob ^ (((ob >> 9) & 1) << 5)); }
__host__ __device__ __forceinline__ void stage_rc(int b, int& R, int& C) { const int st = b / 1024, sb = b % 1024, swz = sb ^ (((sb >> 9) & 1) << 5); R = (st >> 1) * 16 + swz / 64; C = (st & 1) * 32 + (swz % 64) / 2; }
__host__ __device__ __forceinline__ int perm32(int rho) { const int n = rho >> 4, i = rho & 15; return 8 * (i >> 2) + 4 * n + (i & 3); }

struct Unit { int pm, pn; };
struct Gemm { const bf16_t* A; const bf16_t* Bt; int M, N, K; };

struct StaticOrder {
    int nM, nN, nwg, G, c;
    __host__ __device__ void init(int M, int N, int G_, int c_) { nM = M / BM; nN = N / BM; nwg = nM * nN; G = G_; c = c_; }
    __host__ __device__ bool next(int i, Unit& u) const {
        const long L = (long)i * G + c; if (L >= nwg) return false;
        int wgid = (int)L; { const int q = nwg / NXCD, r = nwg % NXCD, xcd = wgid % NXCD, off = wgid / NXCD; wgid = (xcd < r ? xcd * (q + 1) : r * (q + 1) + (xcd - r) * q) + off; }
        const int nig = WGM * nN, gid = wgid / nig, fm = gid * WGM, gsz = (nM - fm) < WGM ? (nM - fm) : WGM;
        u.pm = fm + ((wgid % nig) % gsz); u.pn = (wgid % nig) / gsz; return true;
    }
    __device__ __forceinline__ void a_ready(const Unit&) const {}
    __device__ __forceinline__ void done(const Unit&) const {}
};

__device__ __forceinline__ unsigned cvt_pk_bf16(float lo, float hi) { unsigned r; asm volatile("v_cvt_pk_bf16_f32 %0, %1, %2" : "=v"(r) : "v"(lo), "v"(hi)); return r; }
typedef float f32x2 __attribute__((ext_vector_type(2)));

constexpr int MT = 33792;
constexpr int MP = 32768;
constexpr size_t OFF_PKV = (size_t)MT * 1024;
constexpr size_t OFF_SKV = OFF_PKV + 4ull * MP * 512;
constexpr float RMS_EPS = 1e-6f;
constexpr float LOG2E = 1.4426950408889634f;
typedef float f32x2 __attribute__((ext_vector_type(2)));

struct EpiQKV {
    static constexpr bool PERM = true, AFTER_DRAIN = false;
    bf16_t* qkv; float* out; float qscale;
    __device__ __forceinline__ void operator()(const f32x4 (&acc)[2][2][4][2], const Unit& u, int wr, int wc, int fr, int fq) const {
        const int seg = u.pn >> 1;
        const bool isq = (seg == 0) || (seg == 3);
        const float sc = isq ? qscale : 1.f;
        const int row0 = u.pm * BM + wr * 64 + fr, col0 = u.pn * BM + wc * 32 + 8 * fq;
        const int oi = (seg == 1) ? 0 : (seg == 2) ? 1 : (seg == 4) ? 2 : 3;
        const bool prompt = u.pm < (MP / BM);
        float* obase = prompt ? out + OFF_PKV + (size_t)oi * ((size_t)MP * 512) : out + OFF_SKV + (size_t)oi * (1024 * 512);
        const int orow0 = prompt ? row0 : row0 - MP;
        const int ocol0 = (u.pn & 1) * 256 + wc * 32 + 8 * fq;
#pragma unroll
        for (int ai = 0; ai < 2; ++ai)
#pragma unroll
            for (int m = 0; m < 4; ++m) {
                const int rr = ai * HALF + m * 16;
#pragma unroll
                for (int bj = 0; bj < 2; ++bj) {
                    const f32x4 v0 = acc[ai][bj][m][0], v1 = acc[ai][bj][m][1];
                    if (!isq) { float* op = obase + (size_t)(orow0 + rr) * 512 + ocol0 + bj * HALF; __builtin_nontemporal_store(v0, (f32x4*)op); __builtin_nontemporal_store(v1, (f32x4*)(op + 4)); }
                    u32x4 w; w.x = cvt_pk_bf16(v0[0] * sc, v0[1] * sc); w.y = cvt_pk_bf16(v0[2] * sc, v0[3] * sc); w.z = cvt_pk_bf16(v1[0] * sc, v1[1] * sc); w.w = cvt_pk_bf16(v1[2] * sc, v1[3] * sc);
                    *(u32x4*)(qkv + (size_t)(row0 + rr) * 3072 + col0 + bj * HALF) = w;
                }
            }
    }
};

struct EpiRes {
    static constexpr bool PERM = true, AFTER_DRAIN = false;
    const float* bp; const float* bs; float* Y; bf16_t* hb; float* ssq;
    __device__ __forceinline__ void operator()(const f32x4 (&acc)[2][2][4][2], const Unit& u, int wr, int wc, int fr, int fq) const {
        const int row0 = u.pm * BM + wr * 64 + fr, col0 = u.pn * BM + wc * 32 + 8 * fq;
        const bool prompt = u.pm < (MP / BM);
#pragma unroll
        for (int ai = 0; ai < 2; ++ai)
#pragma unroll
            for (int m = 0; m < 4; ++m) {
                const int row = row0 + ai * HALF + m * 16;
                const float* b = prompt ? bp + (size_t)row * 1024 : bs + (size_t)(row - MP) * 1024;
                float s = 0.f;
#pragma unroll
                for (int bj = 0; bj < 2; ++bj) {
                    const int col = col0 + bj * HALF;
                    const f32x4 v0 = acc[ai][bj][m][0] + *(const f32x4*)(b + col), v1 = acc[ai][bj][m][1] + *(const f32x4*)(b + col + 4);
                    float* yp = Y + (size_t)row * 1024 + col;
                    if (hb) { __builtin_nontemporal_store(v0, (f32x4*)yp); __builtin_nontemporal_store(v1, (f32x4*)(yp + 4)); }
                    else { *(f32x4*)yp = v0; *(f32x4*)(yp + 4) = v1; }
                    if (hb) { u32x4 w; w.x = cvt_pk_bf16(v0[0], v0[1]); w.y = cvt_pk_bf16(v0[2], v0[3]); w.z = cvt_pk_bf16(v1[0], v1[1]); w.w = cvt_pk_bf16(v1[2], v1[3]);
                        *(u32x4*)(hb + (size_t)row * 1024 + col) = w; }
                    s += (v0[0] * v0[0] + v0[1] * v0[1]) + (v0[2] * v0[2] + v0[3] * v0[3]) + (v1[0] * v1[0] + v1[1] * v1[1]) + (v1[2] * v1[2] + v1[3] * v1[3]);
                }
                s += __shfl_xor(s, 16); s += __shfl_xor(s, 32);
                if (fq == 0) ssq[((size_t)u.pn * MT + row) * 4 + wc] = s;
            }
    }
};

struct EpiSwiGLU {
    static constexpr bool PERM = true, AFTER_DRAIN = false;
    bf16_t* act; const float* ssq;
    __device__ __forceinline__ void operator()(const f32x4 (&acc)[2][2][4][2], const Unit& u, int wr, int wc, int fr, int fq) const {
        const int row0 = u.pm * BM + wr * 64 + fr, col0 = u.pn * HALF + wc * 32 + 8 * fq;
#pragma unroll
        for (int ai = 0; ai < 2; ++ai)
#pragma unroll
            for (int m = 0; m < 4; ++m) {
                const int row = row0 + ai * HALF + m * 16;
                const f32x4 a = *(const f32x4*)(ssq + (size_t)row * 4), b = *(const f32x4*)(ssq + ((size_t)MT + row) * 4), c = *(const f32x4*)(ssq + ((size_t)2 * MT + row) * 4), d = *(const f32x4*)(ssq + ((size_t)3 * MT + row) * 4);
                const float tot = ((a[0] + a[1]) + (a[2] + a[3])) + ((b[0] + b[1]) + (b[2] + b[3])) + ((c[0] + c[1]) + (c[2] + c[3])) + ((d[0] + d[1]) + (d[2] + d[3]));
                const float rstd = __builtin_amdgcn_rsqf(tot * (1.0f / 1024.0f) + RMS_EPS);
                float o[8];
#pragma unroll
                for (int n = 0; n < 2; ++n)
#pragma unroll
                    for (int i = 0; i < 4; ++i) {
                        const float g = acc[ai][0][m][n][i] * rstd, up = acc[ai][1][m][n][i] * rstd;
                        o[n * 4 + i] = g * __builtin_amdgcn_rcpf(1.f + __builtin_amdgcn_exp2f(__builtin_fmaxf(-g * LOG2E, -126.f))) * up;
                    }
                u32x4 w; w.x = cvt_pk_bf16(o[0], o[1]); w.y = cvt_pk_bf16(o[2], o[3]); w.z = cvt_pk_bf16(o[4], o[5]); w.w = cvt_pk_bf16(o[6], o[7]);
                *(u32x4*)(act + (size_t)row * 2816 + col0) = w;
            }
    }
};
template <class Epi, class Sched, bool ALIGN_EPI = false, bool SP2 = false>
__device__ __forceinline__ void gemm_phase(PG8_LAS unsigned char* lds, const Gemm g, const Sched& S, const Epi& E) {
    const int tid = threadIdx.x, wid = __builtin_amdgcn_readfirstlane(tid >> 6), lane = tid & 63, wr = wid >> 2, wc = wid & 3, fr = lane & 15, fq = lane >> 4;
    const int K = g.K, nt = K / BK;
    unsigned voffA[2], voffB[2];
#pragma unroll
    for (int i = 0; i < 2; ++i) { int R, C; stage_rc(tid * 16 + i * 8192, R, C); const int Rb = Epi::PERM ? ((R & ~31) + perm32(R & 31)) : R;
        voffA[i] = (unsigned)(R * K + C) * 2u; voffB[i] = (unsigned)(Rb * K + C) * 2u; }
    const size_t kstep = (size_t)(BK * 2);
    const size_t hstep = (size_t)HALF * K * 2;
    const size_t tstep = 2 * hstep;
    const unsigned ldsw = (unsigned)wid * 1024u;
    const int aoff = lds_byte(wr * 64 + fr, fq * 8), boff = lds_byte(wc * 32 + fr, fq * 8);
#define PG8_SA(b, h) (((b) * 2 + (h)) * HTB)
#define PG8_SB(b, h) ((4 + (b) * 2 + (h)) * HTB)
#define PG8_STAGE(bufoff, gbase, voff) do { _Pragma("unroll") for (int _i = 0; _i < 2; ++_i) \
        __builtin_amdgcn_global_load_lds((const unsigned*)((const char*)(gbase) + (voff)[_i]), (PG8_LAS unsigned*)(lds + (bufoff) + ldsw + _i * 8192), 16, 0, 0); } while (0)
#define PG8_LDA(dst, b, h) do { _Pragma("unroll") for (int m = 0; m < 4; ++m) _Pragma("unroll") for (int k = 0; k < 2; ++k) dst[m][k] = *(const PG8_LAS bf16x8*)(lds + PG8_SA(b, h) + aoff + m * 2048 + k * 1024); } while (0)
#define PG8_LDB(dst, b, h) do { _Pragma("unroll") for (int n = 0; n < 2; ++n) _Pragma("unroll") for (int k = 0; k < 2; ++k) dst[n][k] = *(const PG8_LAS bf16x8*)(lds + PG8_SB(b, h) + boff + n * 2048 + k * 1024); } while (0)
#define PG8_MMA(ai, bj, At, Bt) do { __builtin_amdgcn_s_setprio(1); _Pragma("unroll") for (int m = 0; m < 4; ++m) _Pragma("unroll") for (int n = 0; n < 2; ++n) _Pragma("unroll") for (int k = 0; k < 2; ++k) \
        acc[ai][bj][m][n] = __builtin_amdgcn_mfma_f32_16x16x32_bf16(Bt[n][k], At[m][k], acc[ai][bj][m][n], 0, 0, 0); __builtin_amdgcn_s_setprio(0); } while (0)
#define PG8_WAIT_V(n) asm volatile("s_waitcnt vmcnt(" #n ")" ::: "memory")
#define PG8_WAIT_L(n) asm volatile("s_waitcnt lgkmcnt(" #n ")" ::: "memory")
#define PG8_BAR __builtin_amdgcn_s_barrier()
#define PG8_SCHED __builtin_amdgcn_sched_barrier(0)
    Unit cur, nxt; int ui = 0;
    if (!S.next(0, cur)) return;
    f32x4 acc[2][2][4][2];
#pragma unroll
    for (int a = 0; a < 2; ++a)
#pragma unroll
        for (int b = 0; b < 2; ++b)
#pragma unroll
            for (int m = 0; m < 4; ++m)
#pragma unroll
                for (int n = 0; n < 2; ++n) acc[a][b][m][n] = (f32x4){0.f, 0.f, 0.f, 0.f};
    bf16x8 At[4][2], B0[2][2], B1[2][2];
    const char* cA = (const char*)g.A + (size_t)cur.pm * tstep; const char* cB = (const char*)g.Bt + (size_t)cur.pn * tstep;
    S.a_ready(cur);
    if constexpr (SP2) {
        PG8_STAGE(PG8_SB(0, 0), cB, voffB); PG8_STAGE(PG8_SB(0, 1), cB + hstep, voffB); PG8_STAGE(PG8_SA(0, 0), cA, voffA); PG8_STAGE(PG8_SA(0, 1), cA + hstep, voffA);
        if (wr == 1) PG8_BAR;
        PG8_WAIT_V(2); PG8_BAR;
        PG8_STAGE(PG8_SB(1, 0), cB + kstep, voffB); PG8_STAGE(PG8_SA(1, 0), cA + kstep, voffA); PG8_STAGE(PG8_SB(1, 1), cB + hstep + kstep, voffB);
        PG8_WAIT_V(6); PG8_BAR;
    } else {
        PG8_STAGE(PG8_SB(0, 0), cB, voffB); PG8_STAGE(PG8_SA(0, 0), cA, voffA); PG8_STAGE(PG8_SB(0, 1), cB + hstep, voffB); PG8_STAGE(PG8_SA(0, 1), cA + hstep, voffA);
        if (wr == 1) PG8_BAR;
        PG8_WAIT_V(4); PG8_BAR;
        PG8_STAGE(PG8_SB(1, 0), cB + kstep, voffB); PG8_STAGE(PG8_SA(1, 0), cA + kstep, voffA); PG8_STAGE(PG8_SB(1, 1), cB + hstep + kstep, voffB);
        PG8_WAIT_V(6); PG8_BAR;
    }
    for (;;) {
        const bool has_next = S.next(ui + 1, nxt);
        const char* nA = has_next ? (const char*)g.A + (size_t)nxt.pm * tstep : cA; const char* nB = has_next ? (const char*)g.Bt + (size_t)nxt.pn * tstep : cB;
        for (int t = 0; t < nt; t += 2) {
            const bool last = (t == nt - 2);
            const char* a1 = cA + (size_t)(t + 1) * kstep;
            const char* a2 = last ? nA : cA + (size_t)(t + 2) * kstep; const char* b2 = last ? nB : cB + (size_t)(t + 2) * kstep;
            const char* a3 = a2 + kstep; const char* b3 = b2 + kstep;
            if (last && has_next) S.a_ready(nxt);
            if constexpr (SP2) {
            PG8_LDB(B0, 0, 0); PG8_LDB(B1, 0, 1); PG8_SCHED; PG8_LDA(At, 0, 0); PG8_STAGE(PG8_SA(1, 1), a1 + hstep, voffA);
            PG8_WAIT_V(8); PG8_WAIT_L(0); PG8_BAR; PG8_MMA(0, 0, At, B0); PG8_MMA(0, 1, At, B1); PG8_BAR; PG8_SCHED;
            PG8_LDA(At, 0, 1); PG8_STAGE(PG8_SB(0, 0), b2, voffB); PG8_STAGE(PG8_SB(0, 1), b2 + hstep, voffB); PG8_STAGE(PG8_SA(0, 0), a2, voffA);
            PG8_WAIT_V(8); PG8_WAIT_L(0); PG8_BAR; PG8_MMA(1, 0, At, B0); PG8_MMA(1, 1, At, B1); PG8_BAR; PG8_SCHED;
            PG8_LDB(B0, 1, 0); PG8_LDB(B1, 1, 1); PG8_SCHED; PG8_LDA(At, 1, 0); PG8_STAGE(PG8_SA(0, 1), a2 + hstep, voffA);
            PG8_WAIT_V(8); PG8_WAIT_L(0); PG8_BAR; PG8_MMA(0, 0, At, B0); PG8_MMA(0, 1, At, B1); PG8_BAR; PG8_SCHED;
            PG8_LDA(At, 1, 1); PG8_STAGE(PG8_SB(1, 0), b3, voffB); PG8_STAGE(PG8_SB(1, 1), b3 + hstep, voffB); PG8_STAGE(PG8_SA(1, 0), a3, voffA);
            PG8_WAIT_V(8); PG8_WAIT_L(0); PG8_BAR; PG8_MMA(1, 0, At, B0); PG8_MMA(1, 1, At, B1); PG8_BAR; PG8_SCHED;
            } else {
            PG8_LDB(B0, 0, 0); PG8_SCHED; PG8_LDA(At, 0, 0); PG8_STAGE(PG8_SA(1, 1), a1 + hstep, voffA);
            PG8_WAIT_L(8); PG8_BAR; PG8_WAIT_L(0); PG8_MMA(0, 0, At, B0); PG8_BAR; PG8_SCHED;
            PG8_LDB(B1, 0, 1); PG8_STAGE(PG8_SB(0, 0), b2, voffB);
            PG8_BAR; PG8_WAIT_L(0); PG8_MMA(0, 1, At, B1); PG8_BAR;
            PG8_LDA(At, 0, 1); PG8_STAGE(PG8_SA(0, 0), a2, voffA);
            PG8_BAR; PG8_WAIT_L(0); PG8_MMA(1, 0, At, B0); PG8_BAR; PG8_SCHED;
            PG8_STAGE(PG8_SB(0, 1), b2 + hstep, voffB);
            PG8_WAIT_V(6); PG8_BAR; PG8_MMA(1, 1, At, B1); PG8_BAR;
            PG8_LDB(B0, 1, 0); PG8_SCHED; PG8_LDA(At, 1, 0); PG8_STAGE(PG8_SA(0, 1), a2 + hstep, voffA);
            PG8_WAIT_L(8); PG8_BAR; PG8_WAIT_L(0); PG8_MMA(0, 0, At, B0); PG8_BAR; PG8_SCHED;
            PG8_LDB(B1, 1, 1); PG8_STAGE(PG8_SB(1, 0), b3, voffB);
            PG8_BAR; PG8_WAIT_L(0); PG8_MMA(0, 1, At, B1); PG8_BAR;
            PG8_LDA(At, 1, 1); PG8_STAGE(PG8_SA(1, 0), a3, voffA);
            PG8_BAR; PG8_WAIT_L(0); PG8_MMA(1, 0, At, B0); PG8_BAR; PG8_SCHED;
            PG8_STAGE(PG8_SB(1, 1), b3 + hstep, voffB);
            PG8_WAIT_V(6); PG8_BAR; PG8_MMA(1, 1, At, B1); PG8_BAR;
            }
        }
        if constexpr (ALIGN_EPI) { if (wr == 0) PG8_BAR; }
        if constexpr (!Epi::AFTER_DRAIN) { E(acc, cur, wr, wc, fr, fq); S.done(cur); }
        if (!has_next) break;
#pragma unroll
        for (int a = 0; a < 2; ++a)
#pragma unroll
            for (int b = 0; b < 2; ++b)
#pragma unroll
                for (int m = 0; m < 4; ++m)
#pragma unroll
                    for (int n = 0; n < 2; ++n) acc[a][b][m][n] = (f32x4){0.f, 0.f, 0.f, 0.f};
        cur = nxt; cA = nA; cB = nB; ++ui;
        if constexpr (ALIGN_EPI) { if (wr == 1) PG8_BAR; }
    }
    PG8_WAIT_V(0);
    if constexpr (!ALIGN_EPI) { if (wr == 0) PG8_BAR; }
    PG8_BAR;
    if constexpr (Epi::AFTER_DRAIN) { E.fused(acc, cur, wr, wc, fr, fq, lds, wid, lane); S.done(cur); }
#undef PG8_SA
#undef PG8_SB
#undef PG8_STAGE
#undef PG8_LDA
#undef PG8_LDB
#undef PG8_MMA
#undef PG8_WAIT_V
#undef PG8_WAIT_L
#undef PG8_BAR
#undef PG8_SCHED
}
}

namespace att {
#define LAS __attribute__((address_space(3)))
typedef short bf16x8 __attribute__((ext_vector_type(8)));
typedef short s16x4 __attribute__((ext_vector_type(4)));
typedef float f32x16 __attribute__((ext_vector_type(16)));
typedef float f32x4 __attribute__((ext_vector_type(4)));
typedef unsigned u32x4 __attribute__((ext_vector_type(4)));
typedef unsigned u32x2 __attribute__((ext_vector_type(2)));
typedef LAS unsigned char lchar;
typedef unsigned short bf16_t;
constexpr int MP = 32768, LDQ = 3072;
constexpr float LOG2E = 1.4426950408889634f;
constexpr float C2 = 0.125f * LOG2E;
constexpr float NEG_BIG = -1e30f;

struct Params {
    const bf16_t* qkv;
    const float *cdk, *cdv, *csk, *csv;
    bf16_t* mixed;
    unsigned* queue;
    float lam;
};

__device__ __forceinline__ int crow(int r, int hi) { return (r & 3) + 8 * (r >> 2) + 4 * hi; }
typedef float f32x2_t __attribute__((ext_vector_type(2))); typedef __bf16 bf16x2_t __attribute__((ext_vector_type(2)));
__device__ __forceinline__ unsigned cvtpk(float lo, float hi) { const f32x2_t v = {lo, hi}; const bf16x2_t b = __builtin_convertvector(v, bf16x2_t); return __builtin_bit_cast(unsigned, b); }
__device__ __forceinline__ u32x4 pack8(f32x4 a, f32x4 b) { u32x4 w; w.x = cvtpk(a[0], a[1]); w.y = cvtpk(a[2], a[3]); w.z = cvtpk(b[0], b[1]); w.w = cvtpk(b[2], b[3]); return w; }
__device__ __forceinline__ bf16x8 vfrag(const lchar* p0, const lchar* p1) {
    const s16x4 a = __builtin_bit_cast(s16x4, __builtin_amdgcn_ds_read_tr16_b64_v4i16((LAS s16x4*)p0));
    const s16x4 b = __builtin_bit_cast(s16x4, __builtin_amdgcn_ds_read_tr16_b64_v4i16((LAS s16x4*)p1));
    return (bf16x8){a[0], a[1], a[2], a[3], b[0], b[1], b[2], b[3]};
}
__device__ __forceinline__ bf16x8 pfrag(const f32x16& p, int s) {
    u32x4 w; w.x = cvtpk(p[8 * s + 0], p[8 * s + 1]); w.y = cvtpk(p[8 * s + 2], p[8 * s + 3]); w.z = cvtpk(p[8 * s + 4], p[8 * s + 5]); w.w = cvtpk(p[8 * s + 6], p[8 * s + 7]);
    return __builtin_bit_cast(bf16x8, w);
}
__device__ __forceinline__ int offKd(int row, int ch) { return row * 256 + ((ch ^ (row & 15)) << 4); }
__device__ __forceinline__ int offVd(int row, int ch) { return row * 256 + ((ch ^ (((row & 3) << 2) | ((row >> 2) & 3))) << 4); }
__device__ __forceinline__ int offKs(int row, int ch) { return row * 128 + ((ch ^ (row & 7)) << 4); }
__device__ __forceinline__ int offVs(int row, int ch) { return row * 128 + ((ch ^ (((row >> 1) & 1) << 2)) << 4); }

constexpr int DBUF = 32768;
constexpr int SBUF = 16384;

__device__ __forceinline__ void diff_sub(const lchar* Kb, const lchar* Vb, int sub, int map, const bf16x8 (&qf)[4], f32x16 (&O)[4],
                                         float& m0, float& l0, float dq, float sl2, int lane, bool left) {
    const int r32 = lane & 31, hi = lane >> 5;
    f32x16 s;
    if (left) { const float base = -sl2 * dq;
#pragma unroll
        for (int r = 0; r < 16; ++r) s[r] = __builtin_fmaf(sl2, (float)((r & 3) + 8 * (r >> 2)), base); }
    else {
#pragma unroll
        for (int r = 0; r < 16; ++r) s[r] = -sl2 * __builtin_fabsf(dq - (float)((r & 3) + 8 * (r >> 2))); }
    const int krow = sub * 32 + r32;
    bf16x8 kf[4];
#pragma unroll
    for (int ds = 0; ds < 4; ++ds) kf[ds] = *(const LAS bf16x8*)(Kb + offKd(krow, 8 * map + 2 * ds + hi));
    const int q4 = (lane & 15) >> 2, p = lane & 3, g1 = (lane >> 4) & 1;
    bf16x8 vf[2][4];
#pragma unroll
    for (int sk = 0; sk < 2; ++sk)
#pragma unroll
        for (int d = 0; d < 4; ++d) {
            const int ch = d * 4 + 2 * g1 + (p >> 1);
            const int ra = sub * 32 + 16 * sk + 4 * hi + q4, rb = ra + 8;
            vf[sk][d] = vfrag(Vb + offVd(ra, ch) + 8 * (p & 1), Vb + offVd(rb, ch) + 8 * (p & 1));
        }
#pragma unroll
    for (int ds = 0; ds < 4; ++ds) s = __builtin_amdgcn_mfma_f32_32x32x16_bf16(kf[ds], qf[ds], s, 0, 0, 0);
    float mx = s[0];
#pragma unroll
    for (int r = 1; r < 16; ++r) mx = __builtin_fmaxf(mx, s[r]);
    mx = __builtin_fmaxf(mx, __shfl_xor(mx, 32));
    const float n0 = __builtin_fmaxf(m0, mx);
    if (__any(n0 > m0 + 24.f)) {
        const float f0 = __builtin_amdgcn_exp2f(__builtin_fmaxf(m0 - n0, -200.f));
        l0 *= f0;
#pragma unroll
        for (int d = 0; d < 4; ++d)
#pragma unroll
            for (int r = 0; r < 16; ++r) O[d][r] *= f0;
        m0 = n0;
    }
    float a0 = 0.f;
#pragma unroll
    for (int r = 0; r < 16; ++r) { s[r] = __builtin_amdgcn_exp2f(__builtin_fmaxf(s[r] - m0, -200.f)); a0 += s[r]; }
    l0 += a0;
    bf16x8 p0[2];
    p0[0] = pfrag(s, 0); p0[1] = pfrag(s, 1);
#pragma unroll
    for (int sk = 0; sk < 2; ++sk)
#pragma unroll
        for (int d = 0; d < 4; ++d) O[d] = __builtin_amdgcn_mfma_f32_32x32x16_bf16(vf[sk][d], p0[sk], O[d], 0, 0, 0);
}

__device__ __forceinline__ u32x4 ld_f32x8_bf16(const float* p) { const f32x4 a = *(const f32x4*)p, b = *(const f32x4*)(p + 4); return pack8(a, b); }

template <bool SAMPLE>
__device__ __forceinline__ void diff_unit(lchar* lds, const Params& P, const LAS float* gt, int b, int h, int qb) {
    int tid_ = threadIdx.x; asm volatile("" : "+v"(tid_));
    const int tid = tid_, lane = tid & 63, wid = __builtin_amdgcn_readfirstlane(tid >> 6), r32 = lane & 31, hi = lane >> 5;
    const int map = wid & 1, qg = SAMPLE ? ((wid >> 1) & 1) : (wid >> 1);
    const int q0 = SAMPLE ? 0 : qb * 128;
    const size_t qrow_g = SAMPLE ? (size_t)MP + b * 64 + qg * 32 + r32 : (size_t)b * 2048 + q0 + qg * 32 + r32;
    const int qpos = SAMPLE ? 4096 + qg * 32 + r32 : q0 + qg * 32 + r32;
    const int ntiles = SAMPLE ? 65 : 2 * qb + 2;
    const int tw = SAMPLE ? 64 : (q0 + qg * 32) >> 6;
    const bool compute_wave = true;
    const bool epi_wave = SAMPLE ? (wid < 4) : true;
    const int ksub = wid >> 2;
    const float sl2 = __builtin_amdgcn_exp2f(-2.0f * (float)(h + 1)) * LOG2E;
    bf16x8 qf[4];
#pragma unroll
    for (int ds = 0; ds < 4; ++ds) qf[ds] = *(const bf16x8*)(P.qkv + qrow_g * LDQ + h * 128 + map * 64 + ds * 16 + hi * 8);
    f32x16 O[4];
#pragma unroll
    for (int d = 0; d < 4; ++d) O[d] = (f32x16){};
    float m0 = NEG_BIG, l0 = 0.f;

    auto kvbf = [&](int which, int t, int row, int ch) -> const bf16_t* {
        const size_t r = SAMPLE ? (size_t)MP + b * 64 + row : (size_t)b * 2048 + t * 64 + row;
        return P.qkv + r * LDQ + (which ? 1024 : 512) + h * 128 + ch * 8; };
    auto kvf32 = [&](int which, int t, int row, int ch) -> const float* { return (which ? P.cdv : P.cdk) + ((size_t)b * 4096 + t * 64 + row) * 512 + h * 128 + ch * 8; };
    {
        u32x4 rk[2], rv[2]; f32x4 fk[SAMPLE ? 4 : 1], fv[SAMPLE ? 4 : 1];
        auto tile_load = [&](int t) {
#pragma unroll
            for (int i = 0; i < 2; ++i) { const int idx = tid + 512 * i, row = idx >> 4, ch = idx & 15;
                if (SAMPLE && t < 64) { const float* pk = kvf32(0, t, row, ch); const float* pv = kvf32(1, t, row, ch);
                    fk[(2 * i) % (SAMPLE ? 4 : 1)] = __builtin_nontemporal_load((const f32x4*)pk); fk[(2 * i + 1) % (SAMPLE ? 4 : 1)] = __builtin_nontemporal_load((const f32x4*)(pk + 4)); fv[(2 * i) % (SAMPLE ? 4 : 1)] = __builtin_nontemporal_load((const f32x4*)pv); fv[(2 * i + 1) % (SAMPLE ? 4 : 1)] = __builtin_nontemporal_load((const f32x4*)(pv + 4)); }
                else { rk[i] = *(const u32x4*)kvbf(0, t, row, ch); rv[i] = *(const u32x4*)kvbf(1, t, row, ch); } } };
        auto tile_store = [&](int t, lchar* buf) {
#pragma unroll
            for (int i = 0; i < 2; ++i) { const int idx = tid + 512 * i, row = idx >> 4, ch = idx & 15;
                if (SAMPLE && t < 64) { rk[i] = pack8(fk[(2 * i) % (SAMPLE ? 4 : 1)], fk[(2 * i + 1) % (SAMPLE ? 4 : 1)]); rv[i] = pack8(fv[(2 * i) % (SAMPLE ? 4 : 1)], fv[(2 * i + 1) % (SAMPLE ? 4 : 1)]); }
                *(LAS u32x4*)(buf + offKd(row, ch)) = rk[i]; *(LAS u32x4*)(buf + 16384 + offVd(row, ch)) = rv[i]; } };
        tile_load(0); tile_store(0, lds);
        __syncthreads();
        for (int t = 0; t < ntiles; ++t) {
            const lchar* cur = lds + (t & 1) * DBUF; lchar* nxt = lds + ((t + 1) & 1) * DBUF;
            const bool more = (t + 1 < ntiles);
            if (more) tile_load(t + 1);
            if (SAMPLE) diff_sub(cur, cur + 16384, ksub, map, qf, O, m0, l0, (float)(qpos - t * 64 - ksub * 32 - 4 * hi), sl2, lane, (t < 64) || (ksub < qg));
            else if (t <= tw) {
#pragma unroll
                for (int sub = 0; sub < 2; ++sub) diff_sub(cur, cur + 16384, sub, map, qf, O, m0, l0, (float)(qpos - t * 64 - sub * 32 - 4 * hi), sl2, lane, (t * 64 + sub * 32 + 31) < (q0 + qg * 32));
            }
            if (more) tile_store(t + 1, nxt);
            __syncthreads();
        }
    }
    if (SAMPLE) {
        LAS float* cb2 = (LAS float*)lds + (wid & 3) * 4224 + lane;
        if (wid >= 4) { cb2[0] = m0; cb2[64] = l0;
#pragma unroll
            for (int d = 0; d < 4; ++d)
#pragma unroll
                for (int r = 0; r < 16; ++r) cb2[(2 + d * 16 + r) * 64] = O[d][r]; }
        __syncthreads();
        if (wid < 4) { const float mP = cb2[0], lP = cb2[64], mm = __builtin_fmaxf(m0, mP);
            const float f = __builtin_amdgcn_exp2f(__builtin_fmaxf(m0 - mm, -200.f)), fP = __builtin_amdgcn_exp2f(__builtin_fmaxf(mP - mm, -200.f));
            l0 = l0 * f + lP * fP; m0 = mm;
#pragma unroll
            for (int d = 0; d < 4; ++d)
#pragma unroll
                for (int r = 0; r < 16; ++r) O[d][r] = O[d][r] * f + cb2[(2 + d * 16 + r) * 64] * fP; }
        __syncthreads();
    }
    l0 += __shfl_xor(l0, 32);
    LAS float* xb = (LAS float*)lds + qg * 4096 + lane;
    if (epi_wave && map == 1) {
        const float i1 = P.lam / l0;
#pragma unroll
        for (int d = 0; d < 4; ++d)
#pragma unroll
            for (int r = 0; r < 16; ++r) xb[(d * 16 + r) * 64] = O[d][r] * i1;
    }
    __syncthreads();
    if (epi_wave && map == 0) {
        const float i0 = 1.0f / l0;
        float ss = 0.f;
#pragma unroll
        for (int d = 0; d < 4; ++d)
#pragma unroll
            for (int r = 0; r < 16; ++r) { const float o = O[d][r] * i0 - xb[(d * 16 + r) * 64]; O[d][r] = o; ss += o * o; }
        ss += __shfl_xor(ss, 32);
        const float rs = __builtin_amdgcn_rsqf(ss * (1.0f / 128.0f) + 1e-6f) * 0.8f;
        bf16_t* orow = P.mixed + qrow_g * 1024 + h * 128;
#pragma unroll
        for (int d = 0; d < 4; ++d)
#pragma unroll
            for (int G = 0; G < 4; ++G) {
                const int d0 = d * 32 + 8 * G + 4 * hi;
                u32x2 w; w.x = cvtpk(O[d][4 * G + 0] * rs * gt[d0 + 0], O[d][4 * G + 1] * rs * gt[d0 + 1]); w.y = cvtpk(O[d][4 * G + 2] * rs * gt[d0 + 2], O[d][4 * G + 3] * rs * gt[d0 + 3]);
                *(u32x2*)(orow + d0) = w;
            }
    }
}

__device__ __forceinline__ void sb_sub(const lchar* Kb, const lchar* Vb, int sub, bool diag, const bf16x8 (&qf)[4], f32x16 (&O)[2], float& R, int lane) {
    const int r32 = lane & 31, hi = lane >> 5;
    f32x16 z = {};
    const int krow = sub * 32 + r32;
    bf16x8 kf[4];
#pragma unroll
    for (int ds = 0; ds < 4; ++ds) kf[ds] = *(const LAS bf16x8*)(Kb + offKs(krow, 2 * ds + hi));
    const int q4 = (lane & 15) >> 2, p = lane & 3, g1 = (lane >> 4) & 1;
    bf16x8 vf[2][2];
#pragma unroll
    for (int s = 0; s < 2; ++s)
#pragma unroll
        for (int d = 0; d < 2; ++d) {
            const int ch = d * 4 + 2 * g1 + (p >> 1);
            const int ra = sub * 32 + 16 * s + 4 * hi + q4, rb = ra + 8;
            vf[s][d] = vfrag(Vb + offVs(ra, ch) + 8 * (p & 1), Vb + offVs(rb, ch) + 8 * (p & 1));
        }
#pragma unroll
    for (int ds = 0; ds < 4; ++ds) z = __builtin_amdgcn_mfma_f32_32x32x16_bf16(kf[ds], qf[ds], z, 0, 0, 0);
    f32x16 lk;
#pragma unroll
    for (int r = 0; r < 16; ++r) {
        const float zc = __builtin_amdgcn_fmed3f(z[r], -200.f, 80.f);
        float l = -__builtin_amdgcn_logf(1.0f + __builtin_amdgcn_exp2f(zc));
        float ls = zc + l;
        if (diag && !(crow(r, hi) < r32)) { l = 0.f; ls = NEG_BIG; }
        lk[r] = l; z[r] = ls;
    }
    float run = R;
#pragma unroll
    for (int G = 3; G >= 0; --G) {
        const float T = (lk[4 * G] + lk[4 * G + 1]) + (lk[4 * G + 2] + lk[4 * G + 3]);
        const float To = __shfl_xor(T, 32);
        const float a3 = run + (hi == 0 ? To : 0.f);
        const float a2 = a3 + lk[4 * G + 3], a1 = a2 + lk[4 * G + 2], a0 = a1 + lk[4 * G + 1];
        z[4 * G + 3] = __builtin_amdgcn_exp2f(__builtin_fmaxf(z[4 * G + 3] + a3, -200.f)); z[4 * G + 2] = __builtin_amdgcn_exp2f(__builtin_fmaxf(z[4 * G + 2] + a2, -200.f));
        z[4 * G + 1] = __builtin_amdgcn_exp2f(__builtin_fmaxf(z[4 * G + 1] + a1, -200.f)); z[4 * G + 0] = __builtin_amdgcn_exp2f(__builtin_fmaxf(z[4 * G + 0] + a0, -200.f));
        run += T + To;
    }
    R = run;
    bf16x8 pf[2]; pf[0] = pfrag(z, 0); pf[1] = pfrag(z, 1);
#pragma unroll
    for (int s = 0; s < 2; ++s)
#pragma unroll
        for (int d = 0; d < 2; ++d) O[d] = __builtin_amdgcn_mfma_f32_32x32x16_bf16(vf[s][d], pf[s], O[d], 0, 0, 0);
}

__device__ __forceinline__ void sb_unit(const bool SAMPLE, lchar* lds, const Params& P, int b, int h, int qb) {
    int tid_ = threadIdx.x; asm volatile("" : "+v"(tid_));
    const int tid = tid_, lane = tid & 63, wid = __builtin_amdgcn_readfirstlane(tid >> 6), r32 = lane & 31, hi = lane >> 5;
    const int q0 = SAMPLE ? 4096 : qb * 256;
    const int wq0 = q0 + (SAMPLE ? (wid & 1) : wid) * 32;
    const size_t qrow_g = SAMPLE ? (size_t)MP + b * 64 + (wid & 1) * 32 + r32 : (size_t)b * 2048 + wq0 + r32;
    const int thi = SAMPLE ? 64 : 4 * qb + 3;
    const int tw = wq0 >> 6, sw = (wq0 >> 5) & 1;
    const bool compute_wave = SAMPLE ? (wid < 2) : true;
    bf16x8 qf[4];
#pragma unroll
    for (int ds = 0; ds < 4; ++ds) qf[ds] = *(const bf16x8*)(P.qkv + qrow_g * LDQ + 1536 + h * 64 + ds * 16 + hi * 8);
    f32x16 O[2]; O[0] = (f32x16){}; O[1] = (f32x16){};
    float R = 0.f;
    auto compute = [&](int t, const lchar* cur) {
        if (t > tw) return;
        if (__all(R < -160.f)) return;
        if (t == tw) {
            if (sw == 1) { sb_sub(cur, cur + 8192, 1, true, qf, O, R, lane); sb_sub(cur, cur + 8192, 0, false, qf, O, R, lane); }
            else sb_sub(cur, cur + 8192, 0, true, qf, O, R, lane);
        } else { sb_sub(cur, cur + 8192, 1, false, qf, O, R, lane); sb_sub(cur, cur + 8192, 0, false, qf, O, R, lane); }
    };
    auto kvload = [&](int which, int t, int row, int ch) -> u32x4 {
        if (SAMPLE && t < 64) return ld_f32x8_bf16((which ? P.csv : P.csk) + ((size_t)b * 4096 + t * 64 + row) * 512 + h * 64 + ch * 8);
        const size_t r = SAMPLE ? (size_t)MP + b * 64 + row : (size_t)b * 2048 + t * 64 + row;
        return *(const u32x4*)(P.qkv + r * LDQ + (which ? 2560 : 2048) + h * 64 + ch * 8); };
    {
        const int row = tid >> 3, ch = tid & 7;
        u32x4 rk = kvload(0, thi, row, ch), rv = kvload(1, thi, row, ch);
        *(LAS u32x4*)(lds + offKs(row, ch)) = rk; *(LAS u32x4*)(lds + 8192 + offVs(row, ch)) = rv;
        __syncthreads();
        int par = 0;
        volatile LAS int* dflag = (volatile LAS int*)(lds + 131072 + 1600);
        for (int t = thi; t >= 0; --t, par ^= 1) {
            const lchar* cur = lds + par * SBUF; lchar* nxt = lds + (par ^ 1) * SBUF;
            if (t > 0) { rk = kvload(0, t - 1, row, ch); rv = kvload(1, t - 1, row, ch); }
            if (compute_wave) compute(t, cur);
            if (t > 0) { *(LAS u32x4*)(nxt + offKs(row, ch)) = rk; *(LAS u32x4*)(nxt + 8192 + offVs(row, ch)) = rv; }
            const int wdone = (!compute_wave || (t <= tw && __all(R < -160.f))) ? 1 : 0;
            if (lane == 0) dflag[par * 8 + wid] = wdone;
            __syncthreads();
            int alld = 1;
#pragma unroll
            for (int w = 0; w < 8; ++w) alld &= dflag[par * 8 + w];
            if (alld) break;
        }
    }
    if (compute_wave) {
        bf16_t* orow = P.mixed + qrow_g * 1024 + 512 + h * 64;
#pragma unroll
        for (int d = 0; d < 2; ++d)
#pragma unroll
            for (int G = 0; G < 4; ++G) {
                const int d0 = d * 32 + 8 * G + 4 * hi;
                u32x2 w; w.x = cvtpk(O[d][4 * G + 0], O[d][4 * G + 1]); w.y = cvtpk(O[d][4 * G + 2], O[d][4 * G + 3]);
                *(u32x2*)(orow + d0) = w;
            }
    }
}

constexpr int N_UNITS = 192 + 8 * 256;
__device__ __forceinline__ void attn_phase(lchar* lds, Params P, const float* subln_g, int u_base, int u_end) {
    LAS float* gt = (LAS float*)(lds + 131072 + 1024);
    volatile LAS int* slot = (volatile LAS int*)(lds + 131072 + 1536);
    if (threadIdx.x < 128) gt[threadIdx.x] = subln_g[threadIdx.x];
    __syncthreads();
    for (;;) {
        if (threadIdx.x == 0) *slot = u_base + (int)atomicAdd(P.queue, 1u);
        __syncthreads();
        const int u = __builtin_amdgcn_readfirstlane(*slot);
        __syncthreads();
        if (u >= u_end) break;
        if (u < 64) { diff_unit<true>(lds, P, gt, u >> 2, u & 3, 0); }
        else if (u < 192) { const int j = u - 64; sb_unit(true, lds, P, j >> 3, j & 7, 0); }
        else {
            const int j = u - 192, g = 7 - (j >> 8), k = j & 255;
            if (k < 128) { diff_unit<false>(lds, P, gt, (k & 63) >> 2, k & 3, 2 * g + 1 - (k >> 6)); }
            else { const int kk = k - 128; sb_unit(false, lds, P, kk >> 3, kk & 7, g); }
        }
    }
}
#undef LAS
}

#define GAS __attribute__((address_space(1)))
#define LAS __attribute__((address_space(3)))
typedef unsigned short bf16;
typedef unsigned v4u __attribute__((ext_vector_type(4)));
typedef float f32x4 __attribute__((ext_vector_type(4)));
constexpr int NWAVES = 8;
constexpr int MT = 33792, MP = 32768, DM = 1024, NIN = 3072, FF = 2816;
constexpr size_t MiB = 1u << 20;
constexpr size_t WS_CTL = 0;
constexpr size_t WS_WIN = 1 * MiB;
constexpr size_t WS_WOUT = 7 * MiB;
constexpr size_t WS_WGU = 9 * MiB;
constexpr size_t WS_WDN = 20 * MiB;
constexpr size_t WS_SSQ1 = 26 * MiB;
constexpr size_t WS_SSQ2 = 29 * MiB;
constexpr size_t WS_XN = 32 * MiB;
constexpr size_t WS_HB = 100 * MiB;
constexpr size_t WS_QKV = 168 * MiB;
constexpr size_t WS_CACHE = 368 * MiB;
constexpr size_t WS_END = 624 * MiB;
constexpr int RING_BYTES = 131072, LDS_BYTES = 147456;

__device__ __forceinline__ unsigned f2bf(float f) { unsigned u = __builtin_bit_cast(unsigned, f); return (u + 0x7fffu + ((u >> 16) & 1u)) >> 16; }
__device__ __forceinline__ unsigned pk2(float lo, float hi) { return f2bf(lo) | (f2bf(hi) << 16); }
__device__ __forceinline__ float wave_sum(float v) {
#pragma unroll
    for (int o = 1; o < 64; o <<= 1) v += __shfl_xor(v, o);
    return v;
}
__device__ __forceinline__ void transpose_item(const float* W, int K, int N, bf16* WT, int k0, int n0, int orow0, const float* kscale, LAS float* scr, int lane) {
#pragma unroll 8
    for (int i = 0; i < 32; ++i) { const int kk = 2 * i + (lane >> 5); float v = W[(size_t)(k0 + kk) * N + n0 + (lane & 31)]; if (kscale) v *= kscale[k0 + kk]; scr[kk * 33 + (lane & 31)] = v; }
    asm volatile("s_waitcnt lgkmcnt(0)" ::: "memory");
    const int c = lane & 7;
#pragma unroll
    for (int j = 0; j < 4; ++j) { const int n = (lane >> 3) + 8 * j; const LAS float* s = scr + (8 * c) * 33 + n;
        v4u o; o.x = pk2(s[0 * 33], s[1 * 33]); o.y = pk2(s[2 * 33], s[3 * 33]); o.z = pk2(s[4 * 33], s[5 * 33]); o.w = pk2(s[6 * 33], s[7 * 33]);
        *(v4u*)(WT + (size_t)(orow0 + n) * K + k0 + 8 * c) = o; }
    asm volatile("s_waitcnt lgkmcnt(0)" ::: "memory");
}

#define XB_TMO      128
#define XB_XCNT(j)  (256  + 64 * (j))
#define XB_XSUB(j)  (1280 + 64 * (j))
#define XB_XGEN(j)  (2304 + 64 * (j))
#define XB_TOP      3328
#define XB_TOPGEN   3392
#define XCD_BAR_WORDS 3456
#define XB_SPIN_CAP (1u << 18)

__device__ __forceinline__ unsigned xb_ld(unsigned* p)              { return __hip_atomic_load(p, __ATOMIC_RELAXED, __HIP_MEMORY_SCOPE_AGENT); }
__device__ __forceinline__ unsigned xb_add(unsigned* p, unsigned v) { return __hip_atomic_fetch_add(p, v, __ATOMIC_RELAXED, __HIP_MEMORY_SCOPE_AGENT); }
__device__ __forceinline__ unsigned xb_xcc_id() { return (unsigned)__builtin_amdgcn_s_getreg((3 << 11) | 20) & 0xFu; }
#define XB_SPIN(cond, bar) do { unsigned _sp = 0; while (cond) { __builtin_amdgcn_s_sleep(1); \
    if ((++_sp & 255u) == 0u) { if (xb_ld(&(bar)[XB_TMO])) break; if (_sp > XB_SPIN_CAP) { atomicAdd(&(bar)[XB_TMO], 1u); break; } } } } while (0)

struct XcdBarrier {
    unsigned* bar; unsigned x;
    volatile LAS unsigned* st;
};

__device__ __forceinline__ XcdBarrier xcd_barrier_post(unsigned* bar, volatile LAS unsigned* st) {
    XcdBarrier b; b.bar = bar; b.x = xb_xcc_id(); b.st = st;
    if (threadIdx.x == 0) (void)xb_add(&bar[XB_XCNT(b.x)], 1u);
    return b;
}
__device__ __forceinline__ void xcd_barrier_complete(unsigned* bar, unsigned x, unsigned& nloc, unsigned& nx) {
    const unsigned G = gridDim.x * gridDim.y * gridDim.z;
    unsigned sum, cnt, mine, sp = 0u;
    for (;;) {
        sum = 0u; cnt = 0u; mine = 0u;
#pragma unroll
        for (unsigned j = 0; j < 16; ++j) { const unsigned c = xb_ld(&bar[XB_XCNT(j)]); sum += c; cnt += (c > 0u) ? 1u : 0u; mine = (j == x) ? c : mine; }
        if (sum == G) break;
        __builtin_amdgcn_s_sleep(1);
        if ((++sp & 255u) == 0u) { if (xb_ld(&bar[XB_TMO])) break; if (sp > XB_SPIN_CAP) { atomicAdd(&bar[XB_TMO], 1u); break; } }
    }
    nloc = mine > 0u ? mine : 1u; nx = cnt > 0u ? cnt : 1u;
}

__device__ __forceinline__ void xcd_barrier(const XcdBarrier& b) {
    asm volatile("s_waitcnt vmcnt(0)" ::: "memory");
    __syncthreads();
    if (threadIdx.x == 0) {
        unsigned* bar = b.bar;
        __builtin_amdgcn_s_waitcnt(0);
        unsigned nloc = b.st[0], nx = b.st[1];
        if (nloc == 0u) { xcd_barrier_complete(bar, b.x, nloc, nx); b.st[0] = nloc; b.st[1] = nx; }
        const unsigned old = xb_add(&bar[XB_XSUB(b.x)], 1u);
        const unsigned gen = old / nloc;
        if (old + 1u == (gen + 1u) * nloc) {
            __builtin_amdgcn_fence(__ATOMIC_RELEASE, "agent");
            asm volatile("s_waitcnt vmcnt(0)" ::: "memory");
            const unsigned og = xb_add(&bar[XB_TOP], 1u);
            const unsigned tg = og / nx;
            if (og + 1u == (tg + 1u) * nx) xb_add(&bar[XB_TOPGEN], 1u);
            else XB_SPIN(xb_ld(&bar[XB_TOPGEN]) == tg, bar);
            __builtin_amdgcn_fence(__ATOMIC_ACQUIRE, "agent");
            xb_add(&bar[XB_XGEN(b.x)], 1u);
            asm volatile("s_waitcnt vmcnt(0)" ::: "memory");
        } else {
            XB_SPIN(xb_ld(&bar[XB_XGEN(b.x)]) == gen, bar);
            __builtin_amdgcn_fence(__ATOMIC_ACQUIRE, "agent");
            asm volatile("s_waitcnt vmcnt(0)" ::: "memory");
        }
    }
    __syncthreads();
}


struct Args {
    const float* in[19]; float* out; unsigned char* ws; int ph_lo, ph_hi; int isz[20];
};

__global__ void __launch_bounds__(NWAVES * 64, 2) fwd_kernel(Args args) {
    extern __shared__ __attribute__((aligned(16))) unsigned char lds_raw[];
    LAS unsigned char* lds = (LAS unsigned char*)lds_raw;
    const int tid = threadIdx.x, lane = tid & 63, wave = __builtin_amdgcn_readfirstlane(tid >> 6);
    const int G = gridDim.x;
    unsigned char* ws = args.ws;
    const float* xp = args.in[0]; const float* xs = args.in[1];
    float* out = args.out;
    bf16* Win_t = (bf16*)(ws + WS_WIN); bf16* Wout_t = (bf16*)(ws + WS_WOUT); bf16* Wgu_t = (bf16*)(ws + WS_WGU); bf16* Wdn_t = (bf16*)(ws + WS_WDN);
    bf16* XN = (bf16*)(ws + WS_XN); bf16* HB = (bf16*)(ws + WS_HB); bf16* QKV = (bf16*)(ws + WS_QKV); bf16* ACT = (bf16*)(ws + WS_QKV);
    float* SSQ1 = (float*)(ws + WS_SSQ1); float* SSQ2 = (float*)(ws + WS_SSQ2);
    const int lo = args.ph_lo, hi = args.ph_hi;
#define IN(k) (lo <= (k) && (k) < hi)
    unsigned* barw = (unsigned*)(ws + WS_CTL) + 1024;
    volatile LAS unsigned* MISC = (volatile LAS unsigned*)(lds + 131072 + 320);
    if (tid == 0) { MISC[8] = 0u; MISC[9] = 0u; }
    __syncthreads();
    XcdBarrier xbar = xcd_barrier_post(barw, MISC + 8);
    if (args.ph_lo == 0x7fffffff) cg::this_grid().sync();
#define SEAM(k) do { if (IN(k) && IN((k) + 1)) { xcd_barrier(xbar); } } while (0)

    if (IN(0)) {
        if (blockIdx.x == 0 && tid == 0) { __hip_atomic_store((unsigned*)(ws + WS_CTL), 0u, __ATOMIC_RELAXED, __HIP_MEMORY_SCOPE_AGENT); __hip_atomic_store((unsigned*)(ws + WS_CTL) + 64, 0u, __ATOMIC_RELAXED, __HIP_MEMORY_SCOPE_AGENT); }
        LAS float* scr = (LAS float*)(lds + wave * 16384);
        const int gw = blockIdx.x * NWAVES + wave, NGW = G * NWAVES;
        constexpr int I_IN = 16 * 96, I_OUT = 16 * 32, I_G = 16 * 88, I_D = 44 * 32;
        constexpr int NITEMS = I_IN + I_OUT + 2 * I_G + I_D;
        const float* w_in = args.in[7]; const float* w_out = args.in[13]; const float* g_ffn = args.in[14];
        const float* w_gate = args.in[15]; const float* w_up = args.in[16]; const float* w_down = args.in[17];
        for (int it = gw; it < NITEMS; it += NGW) {
            int r = it;
            if (r < I_IN) { const int kb = r / 96, nb = r % 96; transpose_item(w_in, DM, NIN, Win_t, 64 * kb, 32 * nb, 32 * nb, nullptr, scr, lane); continue; } r -= I_IN;
            if (r < I_OUT) { const int kb = r / 32, nb = r % 32; transpose_item(w_out, DM, DM, Wout_t, 64 * kb, 32 * nb, 32 * nb, nullptr, scr, lane); continue; } r -= I_OUT;
            if (r < I_G) { const int kb = r / 88, nb = r % 88, n0 = 32 * nb; transpose_item(w_gate, DM, FF, Wgu_t, 64 * kb, n0, 256 * (n0 >> 7) + (n0 & 127), g_ffn, scr, lane); continue; } r -= I_G;
            if (r < I_G) { const int kb = r / 88, nb = r % 88, n0 = 32 * nb; transpose_item(w_up, DM, FF, Wgu_t, 64 * kb, n0, 256 * (n0 >> 7) + 128 + (n0 & 127), g_ffn, scr, lane); continue; } r -= I_G;
            { const int kb = r / 32, nb = r % 32; transpose_item(w_down, FF, DM, Wdn_t, 64 * kb, 32 * nb, 32 * nb, nullptr, scr, lane); }
        }
        const float* g_attn = args.in[6];
        f32x4 gv[4];
#pragma unroll
        for (int j = 0; j < 4; ++j) gv[j] = ((const f32x4*)g_attn)[lane + 64 * j];
        for (int m = gw; m < MT; m += NGW) {
            const float* xrow = (m < MP) ? xp + (size_t)m * DM : xs + (size_t)(m - MP) * DM;
            const f32x4* xr = (const f32x4*)xrow + lane;
            f32x4 v[4]; float s = 0.f;
#pragma unroll
            for (int j = 0; j < 4; ++j) { v[j] = __builtin_nontemporal_load(&xr[64 * j]); s += (v[j].x * v[j].x + v[j].y * v[j].y) + (v[j].z * v[j].z + v[j].w * v[j].w); }
            const float rstd = __builtin_amdgcn_rsqf(wave_sum(s) * (1.f / DM) + 1e-6f);
            unsigned long long* o8 = (unsigned long long*)(XN + (size_t)m * DM) + lane;
#pragma unroll
            for (int j = 0; j < 4; ++j) { const f32x4 w = v[j] * rstd * gv[j]; o8[64 * j] = (unsigned long long)pk2(w.x, w.y) | ((unsigned long long)pk2(w.z, w.w) << 32); }
        }
    }
    SEAM(0);

    if (IN(1)) {
        pg8::Gemm g{XN, Win_t, MT, NIN, DM}; pg8::StaticOrder S; S.init(MT, NIN, G, (int)blockIdx.x);
        pg8::EpiQKV E{QKV, out, att::C2};
        pg8::gemm_phase<pg8::EpiQKV, pg8::StaticOrder, true, true>(lds, g, S, E);
    }
    SEAM(1);

    if (IN(2)) {
        const float d1 = wave_sum(args.in[8][lane] * args.in[9][lane]), d2 = wave_sum(args.in[10][lane] * args.in[11][lane]);
        att::Params P;
        P.qkv = QKV; P.cdk = args.in[2]; P.cdv = args.in[3]; P.csk = args.in[4]; P.csv = args.in[5]; P.mixed = XN; P.queue = (unsigned*)(ws + WS_CTL);
        P.lam = __expf(d1) - __expf(d2) + 0.2f;
        att::attn_phase(lds, P, args.in[12], 0, att::N_UNITS);
    }
    SEAM(2);

    if (IN(3)) {
        pg8::Gemm g{XN, Wout_t, MT, DM, DM};
        pg8::StaticOrder S; S.init(MT, DM, G, (int)blockIdx.x);
        pg8::EpiRes E{xp, xs, out, HB, SSQ1};
        pg8::gemm_phase<pg8::EpiRes, pg8::StaticOrder, true, true>(lds, g, S, E);
    }
    SEAM(3);

    if (IN(4)) {
        pg8::Gemm g{HB, Wgu_t, MT, 2 * FF, DM}; pg8::StaticOrder S; S.init(MT, 2 * FF, G, (int)blockIdx.x);
        pg8::EpiSwiGLU E{ACT, SSQ1};
        pg8::gemm_phase<pg8::EpiSwiGLU, pg8::StaticOrder, true, true>(lds, g, S, E);
    }
    SEAM(4);

    if (IN(5)) {
        pg8::Gemm g{ACT, Wdn_t, MT, DM, FF}; pg8::StaticOrder S; S.init(MT, DM, G, (int)blockIdx.x);
        pg8::EpiRes E{out, out + (size_t)MP * DM, out, nullptr, SSQ2};
        pg8::gemm_phase<pg8::EpiRes, pg8::StaticOrder, true, true>(lds, g, S, E);
    }
    SEAM(5);

    if (IN(6)) {
        const int gw = blockIdx.x * NWAVES + wave, NGW = G * NWAVES;
        const float* g_fin = args.in[18];
        f32x4 gv[4];
#pragma unroll
        for (int j = 0; j < 4; ++j) gv[j] = ((const f32x4*)g_fin)[lane + 64 * j];
        for (int m = gw; m < MT; m += NGW) {
            const float pss = (lane < 16) ? SSQ2[((size_t)(lane >> 2) * MT + m) * 4 + (lane & 3)] : 0.f;
            const float rstd = __builtin_amdgcn_rsqf(wave_sum(pss) * (1.f / DM) + 1e-6f);
            f32x4* yr = (f32x4*)(out + (size_t)m * DM) + lane;
#pragma unroll
            for (int j = 0; j < 4; ++j) { const f32x4 o = __builtin_nontemporal_load(&yr[64 * j]) * rstd * gv[j]; __builtin_nontemporal_store(o, &yr[64 * j]); }
        }
    }
#undef IN
#undef SEAM
}

#ifndef MK_N_LAUNCHES
#define MK_N_LAUNCHES 1
#endif
extern "C" void kernel_launch(void* const* d_in, const int* in_sizes, int n_in, void* d_out, int out_size, void* d_ws, size_t ws_size, hipStream_t stream) {
    static int grid = 0;
    if (grid == 0) {
        if (n_in != 19 || ws_size < WS_END) { fprintf(stderr, "kernel_launch: unexpected n_in %d or ws_size %zu\n", n_in, ws_size); grid = -1; return; }
        int dev = 0, cus = 0, per_cu = 0;
        hipGetDevice(&dev); hipDeviceGetAttribute(&cus, hipDeviceAttributeMultiprocessorCount, dev);
        hipFuncSetAttribute((const void*)fwd_kernel, hipFuncAttributeMaxDynamicSharedMemorySize, LDS_BYTES);
        hipOccupancyMaxActiveBlocksPerMultiprocessor(&per_cu, (const void*)fwd_kernel, NWAVES * 64, LDS_BYTES);
        if (per_cu < 1) { fprintf(stderr, "kernel_launch: occupancy query says %d blocks per CU\n", per_cu); per_cu = 1; }
        (void)hipGetLastError();
        grid = cus * per_cu;
    }
    if (grid < 0) return;
    (void)hipMemsetAsync((char*)d_ws + WS_CTL, 0, 32768, stream);
    Args a{};
    for (int i = 0; i < 19; ++i) a.in[i] = (const float*)d_in[i];
    a.out = (float*)d_out; a.ws = (unsigned char*)d_ws; for (int i = 0; i < 19; ++i) a.isz[i] = in_sizes[i];
    if (MK_N_LAUNCHES == 1) {
        a.ph_lo = 0; a.ph_hi = 7;
        void* kargs[] = {&a};
        hipError_t e = hipLaunchCooperativeKernel((const void*)fwd_kernel, dim3(grid), dim3(NWAVES * 64), kargs, LDS_BYTES, stream);
        if (e != hipSuccess) fprintf(stderr, "cooperative launch failed: %s (grid %d)\n", hipGetErrorString(e), grid);
    } else {
        for (int ph = 0; ph < 7; ++ph) { a.ph_lo = ph; a.ph_hi = ph + 1; hipLaunchKernelGGL(fwd_kernel, dim3(grid), dim3(NWAVES * 64), LDS_BYTES, stream, a); }
    }
}
```
